# Optimizing an MI355X kernel written in HIP

```python
import jax, jax.numpy as jnp
from jax import lax
import numpy as np

D_MODEL = 1024
BATCH = 8
SEQ = 2048
DEPTH = 4

HEAD_DIM = 64
N_HEADS = D_MODEL // HEAD_DIM
CONV_HEADS = N_HEADS // 4
SG_HEADS = N_HEADS // 4
SB_HEADS = N_HEADS // 2
CONV_WIDTH = CONV_HEADS * HEAD_DIM
SG_WIDTH = SG_HEADS * HEAD_DIM
SB_WIDTH = SB_HEADS * HEAD_DIM
MIX_WIDTH = CONV_WIDTH + SG_WIDTH + SB_WIDTH
CONV_KERNEL = 31
SG_CHUNK = 128
SB_BLOCK = 128
OFF_CONV = 0
OFF_SG = OFF_CONV + 2 * CONV_WIDTH
OFF_SB = OFF_SG + 2 * SG_WIDTH
IN_WIDTH = OFF_SB + 3 * SB_WIDTH
FFN_HIDDEN = ((8 * D_MODEL + 3 * 256 - 1) // (3 * 256)) * 256
RMS_EPS = 1e-6
LN_EPS = 1e-5

kernel_name = "hybrid_conv_gmlp_stickbreaking_trunk"


def rms_norm(x, g):
    xf = x.astype(jnp.float32)
    y = xf * lax.rsqrt(jnp.mean(xf * xf, axis=-1, keepdims=True) + RMS_EPS)
    return (y * g.astype(jnp.float32)).astype(x.dtype)


def layer_norm(x, g, b):
    xf = x.astype(jnp.float32)
    mu = jnp.mean(xf, axis=-1, keepdims=True)
    xc = xf - mu
    var = jnp.mean(xc * xc, axis=-1, keepdims=True)
    y = xc * lax.rsqrt(var + LN_EPS) * g.astype(jnp.float32) + b.astype(jnp.float32)
    return y.astype(x.dtype)


def conv_module(val, gate, conv_w, conv_b, ln_g, ln_b):
    h = val * jax.nn.sigmoid(gate)
    h = lax.conv_general_dilated(
        h, conv_w[:, None, :].astype(h.dtype), window_strides=(1,),
        padding=[(CONV_KERNEL - 1, 0)],
        dimension_numbers=('NWC', 'WIO', 'NWC'),
        feature_group_count=CONV_WIDTH) + conv_b
    h = layer_norm(h, ln_g, ln_b)
    return jax.nn.silu(h)


def spatial_gating(uv, ln_g, ln_b, sg_w, sg_b):
    uv = jax.nn.gelu(uv, approximate=False)
    u, v = uv[..., :SG_WIDTH], uv[..., SG_WIDTH:]
    v = layer_norm(v, ln_g, ln_b)
    bsz, seq, _ = v.shape
    n_chunks = seq // SG_CHUNK
    v = v.reshape(bsz, n_chunks, SG_CHUNK, SG_HEADS, HEAD_DIM)
    causal = jnp.tril(jnp.ones((SG_CHUNK, SG_CHUNK), dtype=bool))
    w = jnp.where(causal[None], sg_w, 0)
    mixed = jnp.einsum('hts,bnshd->bnthd', w, v) + sg_b.T[None, None, :, :, None]
    return u * mixed.reshape(bsz, seq, SG_WIDTH)


def stick_breaking_attention(q, k, v):
    scale = HEAD_DIM ** -0.5
    seq = q.shape[2]
    outs = []
    for blk in range(seq // SB_BLOCK):
        t0 = blk * SB_BLOCK
        kv_len = t0 + SB_BLOCK
        qb = q[:, :, t0:kv_len].astype(jnp.float32)
        kb = k[:, :, :kv_len].astype(jnp.float32)
        vb = v[:, :, :kv_len].astype(jnp.float32)
        z = jnp.einsum('bhtd,bhsd->bhts', qb, kb) * scale
        t_pos = t0 + jnp.arange(SB_BLOCK)
        s_pos = jnp.arange(kv_len)
        causal = s_pos[None, :] < t_pos[:, None]
        log_not_beta = jnp.where(causal, jax.nn.log_sigmoid(-z), 0.0)
        between = lax.cumsum(log_not_beta, axis=3, reverse=True) - log_not_beta
        att = jnp.where(causal, jnp.exp(jax.nn.log_sigmoid(z) + between), 0.0)
        outs.append(jnp.einsum('bhts,bhsd->bhtd', att, vb))
    return jnp.concatenate(outs, axis=2).astype(v.dtype)


def hybrid_layer(x, mix_norm_g, w_in, conv_w, conv_b, conv_ln_g, conv_ln_b,
                 sg_ln_g, sg_ln_b, sg_w, sg_b, q_norm_g, k_norm_g, out_norm_g,
                 w_out, ffn_norm_g, w_gate_up, w_down):
    bsz, seq, _ = x.shape
    h = rms_norm(x, mix_norm_g)
    proj = jnp.einsum('bsd,de->bse', h, w_in)

    y_conv = conv_module(proj[..., OFF_CONV:OFF_CONV + CONV_WIDTH],
                         proj[..., OFF_CONV + CONV_WIDTH:OFF_SG],
                         conv_w, conv_b, conv_ln_g, conv_ln_b)

    y_sg = spatial_gating(proj[..., OFF_SG:OFF_SB], sg_ln_g, sg_ln_b, sg_w, sg_b)

    qkv = proj[..., OFF_SB:].reshape(bsz, seq, 3, SB_HEADS, HEAD_DIM)
    q = rms_norm(qkv[:, :, 0], q_norm_g).transpose(0, 2, 1, 3)
    k = rms_norm(qkv[:, :, 1], k_norm_g).transpose(0, 2, 1, 3)
    v = qkv[:, :, 2].transpose(0, 2, 1, 3)
    y_sb = stick_breaking_attention(q, k, v).transpose(0, 2, 1, 3).reshape(bsz, seq, SB_WIDTH)

    y = jnp.concatenate([
        rms_norm(y_conv, out_norm_g[:CONV_WIDTH]),
        rms_norm(y_sg, out_norm_g[CONV_WIDTH:CONV_WIDTH + SG_WIDTH]),
        rms_norm(y_sb, out_norm_g[CONV_WIDTH + SG_WIDTH:]),
    ], axis=-1)
    x = x + jnp.einsum('bse,ed->bsd', y, w_out)

    h = rms_norm(x, ffn_norm_g)
    gu = jnp.einsum('bsd,df->bsf', h, w_gate_up)
    act = jax.nn.silu(gu[..., :FFN_HIDDEN]) * gu[..., FFN_HIDDEN:]
    return x + jnp.einsum('bsf,fd->bsd', act, w_down)


def setup_inputs(seed: int = 0) -> dict:
    key = jax.random.key(seed)
    ks = jax.random.split(key, 20)
    f32 = jnp.float32
    nrm = lambda k, shape: jax.random.normal(k, shape, dtype=f32)
    L = DEPTH
    return {
        "x": nrm(ks[0], (BATCH, SEQ, D_MODEL)),
        "mix_norm_g": 1.0 + 0.02 * nrm(ks[1], (L, D_MODEL)),
        "w_in": nrm(ks[2], (L, D_MODEL, IN_WIDTH)) * D_MODEL ** -0.5,
        "conv_w": nrm(ks[3], (L, CONV_KERNEL, CONV_WIDTH)) * CONV_KERNEL ** -0.5,
        "conv_b": 0.02 * nrm(ks[4], (L, CONV_WIDTH)),
        "conv_ln_g": 1.0 + 0.02 * nrm(ks[5], (L, CONV_WIDTH)),
        "conv_ln_b": 0.02 * nrm(ks[6], (L, CONV_WIDTH)),
        "sg_ln_g": 1.0 + 0.02 * nrm(ks[7], (L, SG_WIDTH)),
        "sg_ln_b": 0.02 * nrm(ks[8], (L, SG_WIDTH)),
        "sg_w": nrm(ks[9], (L, SG_HEADS, SG_CHUNK, SG_CHUNK)) * SG_CHUNK ** -0.5,
        "sg_b": 1.0 + 0.1 * nrm(ks[10], (L, SG_HEADS, SG_CHUNK)),
        "q_norm_g": 1.0 + 0.02 * nrm(ks[11], (L, HEAD_DIM)),
        "k_norm_g": 1.0 + 0.02 * nrm(ks[12], (L, HEAD_DIM)),
        "out_norm_g": 1.0 + 0.02 * nrm(ks[13], (L, MIX_WIDTH)),
        "w_out": nrm(ks[14], (L, MIX_WIDTH, D_MODEL)) * MIX_WIDTH ** -0.5,
        "ffn_norm_g": 1.0 + 0.02 * nrm(ks[15], (L, D_MODEL)),
        "w_gate_up": nrm(ks[16], (L, D_MODEL, 2 * FFN_HIDDEN)) * D_MODEL ** -0.5,
        "w_down": nrm(ks[17], (L, FFN_HIDDEN, D_MODEL)) * FFN_HIDDEN ** -0.5,
    }


def reference(x, mix_norm_g, w_in, conv_w, conv_b, conv_ln_g, conv_ln_b,
              sg_ln_g, sg_ln_b, sg_w, sg_b, q_norm_g, k_norm_g, out_norm_g,
              w_out, ffn_norm_g, w_gate_up, w_down):
    for l in range(DEPTH):
        x = hybrid_layer(x, mix_norm_g[l], w_in[l], conv_w[l], conv_b[l],
                         conv_ln_g[l], conv_ln_b[l], sg_ln_g[l], sg_ln_b[l],
                         sg_w[l], sg_b[l], q_norm_g[l], k_norm_g[l], out_norm_g[l],
                         w_out[l], ffn_norm_g[l], w_gate_up[l], w_down[l])
    return x
```

```cpp
#include <hip/hip_runtime.h>
#include <hip/hip_cooperative_groups.h>
#include <cstdio>
#include <cstdint>
namespace cg = cooperative_groups;
namespace pg8 {
#define PG8_LAS __attribute__((address_space(3)))
typedef unsigned short bf16_t;
typedef short bf16x8 __attribute__((ext_vector_type(8)));
typedef float f32x4 __attribute__((ext_vector_type(4)));
typedef unsigned u32x4 __attribute__((ext_vector_type(4)));
constexpr int BM = 256, BK = 64, HALF = 128, HTB = HALF * BK * 2  , STAGE_BYTES = 8 * HTB, NXCD = 8, WGM = 8;

__host__ __device__ __forceinline__ int lds_byte(int r, int c) { const int st = (r >> 4) * 2 + (c >> 5), rr = r & 15, cc = c & 31, ob = rr * 64 + cc * 2; return st * 1024 + (ob ^ (((ob >> 9) & 1) << 5)); }
__host__ __device__ __forceinline__ void stage_rc(int b, int& R, int& C) { const int st = b / 1024, sb = b % 1024, swz = sb ^ (((sb >> 9) & 1) << 5); R = (st >> 1) * 16 + swz / 64; C = (st & 1) * 32 + (swz % 64) / 2; }
__host__ __device__ __forceinline__ int perm32(int rho) { const int n = rho >> 4, i = rho & 15; return 8 * (i >> 2) + 4 * n + (i & 3); }

struct Unit { int pm, pn; };
struct Gemm { const bf16_t* A; const bf16_t* Bt; int M, N, K; };

struct StaticOrder {
    int nM, nN, nwg, G, c;
    __host__ __device__ void init(int M, int N, int G_, int c_) { nM = M / BM; nN = N / BM; nwg = nM * nN; G = G_; c = c_; }
    __host__ __device__ bool next(int i, Unit& u) const {
        const long L = (long)i * G + c; if (L >= nwg) return false;
        int wgid = (int)L; { const int q = nwg / NXCD, r = nwg % NXCD, xcd = wgid % NXCD, off = wgid / NXCD; wgid = (xcd < r ? xcd * (q + 1) : r * (q + 1) + (xcd - r) * q) + off; }
        const int nig = WGM * nN, gid = wgid / nig, fm = gid * WGM, gsz = (nM - fm) < WGM ? (nM - fm) : WGM;
        u.pm = fm + ((wgid % nig) % gsz); u.pn = (wgid % nig) / gsz; return true;
    }
    __device__ __forceinline__ void a_ready(const Unit&) const {}
    __device__ __forceinline__ void done(const Unit&) const {}
};

__device__ __forceinline__ unsigned cvt_pk_bf16(float lo, float hi) { unsigned r; asm volatile("v_cvt_pk_bf16_f32 %0, %1, %2" : "=v"(r) : "v"(lo), "v"(hi)); return r; }
typedef float f32x2 __attribute__((ext_vector_type(2)));
template <class Epi, class Sched, bool ALIGN_EPI = false, bool SP2 = false>
__device__ __forceinline__ void gemm_phase(PG8_LAS unsigned char* lds, const Gemm g, const Sched& S, const Epi& E) {
    int tid_l = threadIdx.x; asm volatile("" : "+v"(tid_l)); const int tid = tid_l, wid = __builtin_amdgcn_readfirstlane(tid >> 6), lane = tid & 63, wr = wid >> 2, wc = wid & 3, fr = lane & 15, fq = lane >> 4;
    const int K = g.K, nt = K / BK;
    unsigned voffA[2], voffB[2];
#pragma unroll
    for (int i = 0; i < 2; ++i) { int R, C; stage_rc(tid * 16 + i * 8192, R, C); const int Rb = Epi::PERM ? ((R & ~31) + perm32(R & 31)) : R;
        voffA[i] = (unsigned)(R * K + C) * 2u; voffB[i] = (unsigned)(Rb * K + C) * 2u; }
    const size_t kstep = (size_t)(BK * 2);
    const size_t hstep = (size_t)HALF * K * 2;
    const size_t tstep = 2 * hstep;
    const unsigned ldsw = (unsigned)wid * 1024u;
    const int aoff = lds_byte(wr * 64 + fr, fq * 8), boff = lds_byte(wc * 32 + fr, fq * 8);
#define PG8_SA(b, h) (((b) * 2 + (h)) * HTB)
#define PG8_SB(b, h) ((4 + (b) * 2 + (h)) * HTB)
#define PG8_STAGE(bufoff, gbase, voff) do { _Pragma("unroll") for (int _i = 0; _i < 2; ++_i) \
        __builtin_amdgcn_global_load_lds((const unsigned*)((const char*)(gbase) + (voff)[_i]), (PG8_LAS unsigned*)(lds + (bufoff) + ldsw + _i * 8192), 16, 0, 0); } while (0)
#define PG8_LDA(dst, b, h) do { _Pragma("unroll") for (int m = 0; m < 4; ++m) _Pragma("unroll") for (int k = 0; k < 2; ++k) dst[m][k] = *(const PG8_LAS bf16x8*)(lds + PG8_SA(b, h) + aoff + m * 2048 + k * 1024); } while (0)
#define PG8_LDB(dst, b, h) do { _Pragma("unroll") for (int n = 0; n < 2; ++n) _Pragma("unroll") for (int k = 0; k < 2; ++k) dst[n][k] = *(const PG8_LAS bf16x8*)(lds + PG8_SB(b, h) + boff + n * 2048 + k * 1024); } while (0)
#define PG8_MMA(ai, bj, At, Bt) do { __builtin_amdgcn_s_setprio(1); _Pragma("unroll") for (int m = 0; m < 4; ++m) _Pragma("unroll") for (int n = 0; n < 2; ++n) _Pragma("unroll") for (int k = 0; k < 2; ++k) \
        acc[ai][bj][m][n] = __builtin_amdgcn_mfma_f32_16x16x32_bf16(Bt[n][k], At[m][k], acc[ai][bj][m][n], 0, 0, 0); __builtin_amdgcn_s_setprio(0); } while (0)
#define PG8_WAIT_V(n) asm volatile("s_waitcnt vmcnt(" #n ")" ::: "memory")
#define PG8_WAIT_L(n) asm volatile("s_waitcnt lgkmcnt(" #n ")" ::: "memory")
#define PG8_BAR __builtin_amdgcn_s_barrier()
#define PG8_SCHED __builtin_amdgcn_sched_barrier(0)
    Unit cur, nxt; int ui = 0;
    if (!S.next(0, cur)) return;
    f32x4 acc[2][2][4][2];
#pragma unroll
    for (int a = 0; a < 2; ++a)
#pragma unroll
        for (int b = 0; b < 2; ++b)
#pragma unroll
            for (int m = 0; m < 4; ++m)
#pragma unroll
                for (int n = 0; n < 2; ++n) acc[a][b][m][n] = (f32x4){0.f, 0.f, 0.f, 0.f};
    bf16x8 At[4][2], B0[2][2], B1[2][2];
    const char* cA = (const char*)g.A + (size_t)cur.pm * tstep; const char* cB = (const char*)g.Bt + (size_t)cur.pn * tstep;
    S.a_ready(cur);
    if constexpr (SP2) {
        PG8_STAGE(PG8_SB(0, 0), cB, voffB); PG8_STAGE(PG8_SB(0, 1), cB + hstep, voffB); PG8_STAGE(PG8_SA(0, 0), cA, voffA); PG8_STAGE(PG8_SA(0, 1), cA + hstep, voffA);
        if (wr == 1) PG8_BAR;
        PG8_WAIT_V(2); PG8_BAR;
        PG8_STAGE(PG8_SB(1, 0), cB + kstep, voffB); PG8_STAGE(PG8_SA(1, 0), cA + kstep, voffA); PG8_STAGE(PG8_SB(1, 1), cB + hstep + kstep, voffB);
        PG8_WAIT_V(6); PG8_BAR;
    } else {
        PG8_STAGE(PG8_SB(0, 0), cB, voffB); PG8_STAGE(PG8_SA(0, 0), cA, voffA); PG8_STAGE(PG8_SB(0, 1), cB + hstep, voffB); PG8_STAGE(PG8_SA(0, 1), cA + hstep, voffA);
        if (wr == 1) PG8_BAR;
        PG8_WAIT_V(4); PG8_BAR;
        PG8_STAGE(PG8_SB(1, 0), cB + kstep, voffB); PG8_STAGE(PG8_SA(1, 0), cA + kstep, voffA); PG8_STAGE(PG8_SB(1, 1), cB + hstep + kstep, voffB);
        PG8_WAIT_V(6); PG8_BAR;
    }
    for (;;) {
        const bool has_next = S.next(ui + 1, nxt);
        const char* nA = has_next ? (const char*)g.A + (size_t)nxt.pm * tstep : cA; const char* nB = has_next ? (const char*)g.Bt + (size_t)nxt.pn * tstep : cB;
        for (int t = 0; t < nt; t += 2) {
            const bool last = (t == nt - 2);
            const char* a1 = cA + (size_t)(t + 1) * kstep;
            const char* a2 = last ? nA : cA + (size_t)(t + 2) * kstep; const char* b2 = last ? nB : cB + (size_t)(t + 2) * kstep;
            const char* a3 = a2 + kstep; const char* b3 = b2 + kstep;
            if (last && has_next) S.a_ready(nxt);
            if constexpr (SP2) {
            PG8_LDB(B0, 0, 0); PG8_LDB(B1, 0, 1); PG8_SCHED; PG8_LDA(At, 0, 0); PG8_STAGE(PG8_SA(1, 1), a1 + hstep, voffA);
            PG8_WAIT_V(8); PG8_WAIT_L(0); PG8_BAR; PG8_MMA(0, 0, At, B0); PG8_MMA(0, 1, At, B1); PG8_BAR; PG8_SCHED;
            PG8_LDA(At, 0, 1); PG8_STAGE(PG8_SB(0, 0), b2, voffB); PG8_STAGE(PG8_SB(0, 1), b2 + hstep, voffB); PG8_STAGE(PG8_SA(0, 0), a2, voffA);
            PG8_WAIT_V(8); PG8_WAIT_L(0); PG8_BAR; PG8_MMA(1, 0, At, B0); PG8_MMA(1, 1, At, B1); PG8_BAR; PG8_SCHED;
            PG8_LDB(B0, 1, 0); PG8_LDB(B1, 1, 1); PG8_SCHED; PG8_LDA(At, 1, 0); PG8_STAGE(PG8_SA(0, 1), a2 + hstep, voffA);
            PG8_WAIT_V(8); PG8_WAIT_L(0); PG8_BAR; PG8_MMA(0, 0, At, B0); PG8_MMA(0, 1, At, B1); PG8_BAR; PG8_SCHED;
            PG8_LDA(At, 1, 1); PG8_STAGE(PG8_SB(1, 0), b3, voffB); PG8_STAGE(PG8_SB(1, 1), b3 + hstep, voffB); PG8_STAGE(PG8_SA(1, 0), a3, voffA);
            PG8_WAIT_V(8); PG8_WAIT_L(0); PG8_BAR; PG8_MMA(1, 0, At, B0); PG8_MMA(1, 1, At, B1); PG8_BAR; PG8_SCHED;
            } else {
            PG8_LDB(B0, 0, 0); PG8_SCHED; PG8_LDA(At, 0, 0); PG8_STAGE(PG8_SA(1, 1), a1 + hstep, voffA);
            PG8_WAIT_L(8); PG8_BAR; PG8_WAIT_L(0); PG8_MMA(0, 0, At, B0); PG8_BAR; PG8_SCHED;
            PG8_LDB(B1, 0, 1); PG8_STAGE(PG8_SB(0, 0), b2, voffB);
            PG8_BAR; PG8_WAIT_L(0); PG8_MMA(0, 1, At, B1); PG8_BAR;
            PG8_LDA(At, 0, 1); PG8_STAGE(PG8_SA(0, 0), a2, voffA);
            PG8_BAR; PG8_WAIT_L(0); PG8_MMA(1, 0, At, B0); PG8_BAR; PG8_SCHED;
            PG8_STAGE(PG8_SB(0, 1), b2 + hstep, voffB);
            PG8_WAIT_V(6); PG8_BAR; PG8_MMA(1, 1, At, B1); PG8_BAR;
            PG8_LDB(B0, 1, 0); PG8_SCHED; PG8_LDA(At, 1, 0); PG8_STAGE(PG8_SA(0, 1), a2 + hstep, voffA);
            PG8_WAIT_L(8); PG8_BAR; PG8_WAIT_L(0); PG8_MMA(0, 0, At, B0); PG8_BAR; PG8_SCHED;
            PG8_LDB(B1, 1, 1); PG8_STAGE(PG8_SB(1, 0), b3, voffB);
            PG8_BAR; PG8_WAIT_L(0); PG8_MMA(0, 1, At, B1); PG8_BAR;
            PG8_LDA(At, 1, 1); PG8_STAGE(PG8_SA(1, 0), a3, voffA);
            PG8_BAR; PG8_WAIT_L(0); PG8_MMA(1, 0, At, B0); PG8_BAR; PG8_SCHED;
            PG8_STAGE(PG8_SB(1, 1), b3 + hstep, voffB);
            PG8_WAIT_V(6); PG8_BAR; PG8_MMA(1, 1, At, B1); PG8_BAR;
            }
        }
        if constexpr (ALIGN_EPI) { if (wr == 0) PG8_BAR; }
        if constexpr (!Epi::AFTER_DRAIN) { E(acc, cur, wr, wc, fr, fq); S.done(cur); }
        if (!has_next) break;
#pragma unroll
        for (int a = 0; a < 2; ++a)
#pragma unroll
            for (int b = 0; b < 2; ++b)
#pragma unroll
                for (int m = 0; m < 4; ++m)
#pragma unroll
                    for (int n = 0; n < 2; ++n) acc[a][b][m][n] = (f32x4){0.f, 0.f, 0.f, 0.f};
        cur = nxt; cA = nA; cB = nB; ++ui;
        if constexpr (ALIGN_EPI) { if (wr == 1) PG8_BAR; }
    }
    PG8_WAIT_V(0);
    if constexpr (!ALIGN_EPI) { if (wr == 0) PG8_BAR; }
    PG8_BAR;
    if constexpr (Epi::AFTER_DRAIN) { E.fused(acc, cur, wr, wc, fr, fq, lds, wid, lane); S.done(cur); }
#undef PG8_SA
#undef PG8_SB
#undef PG8_STAGE
#undef PG8_LDA
#undef PG8_LDB
#undef PG8_MMA
#undef PG8_WAIT_V
#undef PG8_WAIT_L
#undef PG8_BAR
#undef PG8_SCHED
}
}
#define GAS __attribute__((address_space(1)))
#define LAS __attribute__((address_space(3)))
#define RLX_AGENT __ATOMIC_RELAXED, __HIP_MEMORY_SCOPE_AGENT
#define LDS_WAIT() asm volatile("s_waitcnt lgkmcnt(0)" ::: "memory")
#define VM_WAIT() asm volatile("s_waitcnt vmcnt(0)" ::: "memory")
__device__ __forceinline__ unsigned long long rt() { return __builtin_amdgcn_s_memrealtime(); }
#define XB_TMO      128
#define XB_XCNT(j)  (256  + 64 * (j))
#define XB_XSUB(j)  (1280 + 64 * (j))
#define XB_XGEN(j)  (2304 + 64 * (j))
#define XB_TOP      3328
#define XB_TOPGEN   3392
#define XCD_BAR_WORDS 3456
#define XB_SPIN_CAP (1u << 18)

__device__ __forceinline__ unsigned xb_ld(unsigned* p)              { return __hip_atomic_load(p, __ATOMIC_RELAXED, __HIP_MEMORY_SCOPE_AGENT); }
__device__ __forceinline__ unsigned xb_add(unsigned* p, unsigned v) { return __hip_atomic_fetch_add(p, v, __ATOMIC_RELAXED, __HIP_MEMORY_SCOPE_AGENT); }
__device__ __forceinline__ unsigned xb_xcc_id() { return (unsigned)__builtin_amdgcn_s_getreg((3 << 11) | 20) & 0xFu; }
#define XB_SPIN(cond, bar) do { unsigned _sp = 0; while (cond) { __builtin_amdgcn_s_sleep(1); \
    if ((++_sp & 255u) == 0u) { if (xb_ld(&(bar)[XB_TMO])) break; if (_sp > XB_SPIN_CAP) { atomicAdd(&(bar)[XB_TMO], 1u); break; } } } } while (0)

struct XcdBarrier {
    unsigned* bar; unsigned x;
    volatile LAS unsigned* st;
};

__device__ __forceinline__ XcdBarrier xcd_barrier_post(unsigned* bar, volatile LAS unsigned* st) {
    XcdBarrier b; b.bar = bar; b.x = xb_xcc_id(); b.st = st;
    if (threadIdx.x == 0) (void)xb_add(&bar[XB_XCNT(b.x)], 1u);
    return b;
}
__device__ __forceinline__ void xcd_barrier_complete(unsigned* bar, unsigned x, unsigned& nloc, unsigned& nx) {
    const unsigned G = gridDim.x * gridDim.y * gridDim.z;
    unsigned sum, cnt, mine, sp = 0u;
    for (;;) {
        sum = 0u; cnt = 0u; mine = 0u;
#pragma unroll
        for (unsigned j = 0; j < 16; ++j) { const unsigned c = xb_ld(&bar[XB_XCNT(j)]); sum += c; cnt += (c > 0u) ? 1u : 0u; mine = (j == x) ? c : mine; }
        if (sum == G) break;
        __builtin_amdgcn_s_sleep(1);
        if ((++sp & 255u) == 0u) { if (xb_ld(&bar[XB_TMO])) break; if (sp > XB_SPIN_CAP) { atomicAdd(&bar[XB_TMO], 1u); break; } }
    }
    nloc = mine > 0u ? mine : 1u; nx = cnt > 0u ? cnt : 1u;
}

__device__ __forceinline__ void xcd_barrier(const XcdBarrier& b) {
    asm volatile("s_waitcnt vmcnt(0)" ::: "memory");
    __syncthreads();
    if (threadIdx.x == 0) {
        unsigned* bar = b.bar;
        __builtin_amdgcn_s_waitcnt(0);
        unsigned nloc = b.st[0], nx = b.st[1];
        if (nloc == 0u) { xcd_barrier_complete(bar, b.x, nloc, nx); b.st[0] = nloc; b.st[1] = nx; }
        const unsigned old = xb_add(&bar[XB_XSUB(b.x)], 1u);
        const unsigned gen = old / nloc;
        if (old + 1u == (gen + 1u) * nloc) {
            __builtin_amdgcn_fence(__ATOMIC_RELEASE, "agent");
            asm volatile("s_waitcnt vmcnt(0)" ::: "memory");
            const unsigned og = xb_add(&bar[XB_TOP], 1u);
            const unsigned tg = og / nx;
            if (og + 1u == (tg + 1u) * nx) xb_add(&bar[XB_TOPGEN], 1u);
            else XB_SPIN(xb_ld(&bar[XB_TOPGEN]) == tg, bar);
            __builtin_amdgcn_fence(__ATOMIC_ACQUIRE, "agent");
            xb_add(&bar[XB_XGEN(b.x)], 1u);
            asm volatile("s_waitcnt vmcnt(0)" ::: "memory");
        } else {
            XB_SPIN(xb_ld(&bar[XB_XGEN(b.x)]) == gen, bar);
            __builtin_amdgcn_fence(__ATOMIC_ACQUIRE, "agent");
            asm volatile("s_waitcnt vmcnt(0)" ::: "memory");
        }
    }
    __syncthreads();
}
typedef unsigned short bf16_t;
typedef short bf16x8 __attribute__((ext_vector_type(8)));
typedef float f32x4 __attribute__((ext_vector_type(4)));
typedef float f32x16 __attribute__((ext_vector_type(16)));
typedef unsigned u32x4 __attribute__((ext_vector_type(4)));
typedef unsigned u32x2 __attribute__((ext_vector_type(2)));

constexpr int DM = 1024, NB = 8, SEQ = 2048, DEPTH = 4, M = NB * SEQ, INW = 2560, FFH = 2816, GUW = 5632;
constexpr float RMS_EPS = 1e-6f, LN_EPS = 1e-5f;
constexpr size_t MiB = 1u << 20;
constexpr size_t WS_SS = 0;
constexpr size_t WS_SSB = 256 * MiB;
constexpr size_t WS_BAR = 1536 * 1024, BAR_BYTES = 16384;
constexpr size_t WS_WSG = 1 * MiB;
constexpr size_t WS_W = 2 * MiB;
constexpr size_t W_LAYER = 47 * MiB / 2;
constexpr size_t WOFF_IN = 0, WOFF_OUT = 5 * MiB, WOFF_GU = 7 * MiB, WOFF_DN = 18 * MiB;
constexpr size_t WS_XB = 96 * MiB, WS_Y = 128 * MiB, WS_PROJ = 160 * MiB, WS_VT = 240 * MiB, WS_H = 160 * MiB, WS_END = 257 * MiB;
constexpr int LDS_BYTES = 135168;

__device__ __forceinline__ unsigned cvtpk(float lo, float hi) { typedef float f2 __attribute__((ext_vector_type(2))); typedef __bf16 b2 __attribute__((ext_vector_type(2))); f2 v = {lo, hi}; b2 b = __builtin_convertvector(v, b2); return __builtin_bit_cast(unsigned, b); }
__device__ __forceinline__ bf16_t f2bf(float f) { return (bf16_t)(cvtpk(f, 0.f) & 0xffffu); }
__device__ __forceinline__ float bf2f(unsigned short b) { return __uint_as_float((unsigned)b << 16); }
__device__ __forceinline__ float bflo(unsigned w) { return __uint_as_float(w << 16); }
__device__ __forceinline__ float bfhi(unsigned w) { return __uint_as_float(w & 0xffff0000u); }
__device__ __forceinline__ u32x4 pack8(f32x4 a, f32x4 b) { u32x4 w; w.x = cvtpk(a[0], a[1]); w.y = cvtpk(a[2], a[3]); w.z = cvtpk(b[0], b[1]); w.w = cvtpk(b[2], b[3]); return w; }
__device__ __forceinline__ float dot4(f32x4 a) { return (a[0] * a[0] + a[1] * a[1]) + (a[2] * a[2] + a[3] * a[3]); }
__device__ __forceinline__ float sigmoidf_(float x) { return 1.f / (1.f + __expf(-x)); }
__device__ __forceinline__ float gelu_erf(float x) { return 0.5f * x * (1.f + erff(x * 0.70710678118654752f)); }
__device__ __forceinline__ float wave_sum(float v) {
#pragma unroll
    for (int o = 1; o < 64; o <<= 1) v += __shfl_xor(v, o);
    return v;
}
__device__ __forceinline__ float row_rinv(const float* SS, int row) { const f32x4* p = (const f32x4*)(SS + (size_t)row * 16); const f32x4 a = p[0], b = p[1], c = p[2], d = p[3];
    const float s = ((a[0] + a[1]) + (a[2] + a[3])) + ((b[0] + b[1]) + (b[2] + b[3])) + ((c[0] + c[1]) + (c[2] + c[3])) + ((d[0] + d[1]) + (d[2] + d[3])); return rsqrtf(s * (1.f / 1024.f) + RMS_EPS); }
__device__ __forceinline__ int crow(int r, int hi) { return (r & 3) + 8 * (r >> 2) + 4 * hi; }

struct EpiInProj {
    static constexpr bool PERM = true, AFTER_DRAIN = false;
    bf16_t* PROJ; bf16_t* VT; const float* SS; const float* qg; const float* kg;
    __device__ __forceinline__ void operator()(const pg8::f32x4 (&acc)[2][2][4][2], const pg8::Unit& u, int wr, int wc, int fr, int fq) const {
        const int pn = u.pn;
        const int colbase = pn * 256 + 64 * wc + 8 * fq;
#pragma unroll
        for (int ai = 0; ai < 2; ++ai)
#pragma unroll
            for (int m = 0; m < 4; ++m) {
                const int row = u.pm * 256 + ai * 128 + wr * 64 + m * 16 + fr;
                const float rinv = row_rinv(SS, row);
                f32x4 v[2][2];
#pragma unroll
                for (int bj = 0; bj < 2; ++bj)
#pragma unroll
                    for (int n = 0; n < 2; ++n) v[bj][n] = acc[ai][bj][m][n] * rinv;
                if (pn >= 4 && pn < 8) {
                    float ss = (dot4(v[0][0]) + dot4(v[0][1])) + (dot4(v[1][0]) + dot4(v[1][1]));
                    ss += __shfl_xor(ss, 16); ss += __shfl_xor(ss, 32);
                    const float hr = rsqrtf(ss * (1.f / 64.f) + RMS_EPS) * (pn < 6 ? 0.125f : 1.f);
                    const float* g = pn < 6 ? qg : kg;
#pragma unroll
                    for (int bj = 0; bj < 2; ++bj)
#pragma unroll
                        for (int n = 0; n < 2; ++n) { const f32x4 gv = *(const f32x4*)(g + 32 * bj + 8 * fq + 4 * n); v[bj][n] = v[bj][n] * gv * hr; }
                }
                if (pn < 8) {
#pragma unroll
                    for (int bj = 0; bj < 2; ++bj) *(u32x4*)(PROJ + (size_t)row * INW + colbase + 32 * bj) = pack8(v[bj][0], v[bj][1]);
                } else {
                    const int hd0 = ((pn - 8) * 4 + wc) * 64 + 8 * fq;
#pragma unroll
                    for (int bj = 0; bj < 2; ++bj)
#pragma unroll
                        for (int n = 0; n < 2; ++n)
#pragma unroll
                            for (int j = 0; j < 4; ++j) VT[(size_t)(hd0 + 32 * bj + 4 * n + j) * M + row] = f2bf(v[bj][n][j]);
                }
            }
    }
};
struct EpiRes {
    static constexpr bool PERM = true, AFTER_DRAIN = false;
    const float* base; float* out; bf16_t* XB; float* SSn;
    __device__ __forceinline__ void operator()(const pg8::f32x4 (&acc)[2][2][4][2], const pg8::Unit& u, int wr, int wc, int fr, int fq) const {
        const int col0 = u.pn * 256 + 32 * wc + 8 * fq;
#pragma unroll
        for (int ai = 0; ai < 2; ++ai)
#pragma unroll
            for (int m = 0; m < 4; ++m) {
                const int row = u.pm * 256 + ai * 128 + wr * 64 + m * 16 + fr;
                float ss = 0.f;
#pragma unroll
                for (int bj = 0; bj < 2; ++bj) {
                    const size_t off = (size_t)row * DM + col0 + 128 * bj;
                    const f32x4 b0 = *(const f32x4*)(base + off), b1 = *(const f32x4*)(base + off + 4);
                    const f32x4 v0 = b0 + acc[ai][bj][m][0], v1 = b1 + acc[ai][bj][m][1];
                    *(f32x4*)(out + off) = v0; *(f32x4*)(out + off + 4) = v1;
                    if (XB) { *(u32x4*)(XB + off) = pack8(v0, v1); ss += dot4(v0) + dot4(v1); }
                }
                if (XB) { ss += __shfl_xor(ss, 16); ss += __shfl_xor(ss, 32); if (fq == 0) SSn[(size_t)row * 16 + u.pn * 4 + wc] = ss; }
            }
    }
};
struct EpiSwiglu {
    static constexpr bool PERM = true, AFTER_DRAIN = false;
    bf16_t* H; const float* SS;
    __device__ __forceinline__ void operator()(const pg8::f32x4 (&acc)[2][2][4][2], const pg8::Unit& u, int wr, int wc, int fr, int fq) const {
        const int col0 = u.pn * 128 + 32 * wc + 8 * fq;
#pragma unroll
        for (int ai = 0; ai < 2; ++ai)
#pragma unroll
            for (int m = 0; m < 4; ++m) {
                const int row = u.pm * 256 + ai * 128 + wr * 64 + m * 16 + fr;
                const float rinv = row_rinv(SS, row);
                f32x4 h[2];
#pragma unroll
                for (int n = 0; n < 2; ++n) {
                    const f32x4 g = acc[ai][0][m][n] * rinv, up = acc[ai][1][m][n] * rinv;
#pragma unroll
                    for (int j = 0; j < 4; ++j) h[n][j] = g[j] * sigmoidf_(g[j]) * up[j];
                }
                *(u32x4*)(H + (size_t)row * FFH + col0) = pack8(h[0], h[1]);
            }
    }
};

__device__ __forceinline__ void transpose_item(const float* W, int K, int N, bf16_t* WT, const float* gain, LAS float* scr, int kb, int n0, int src0, int lane) {
    const int k0 = 64 * kb;
#pragma unroll 8
    for (int i = 0; i < 32; ++i) { const int kk = 2 * i + (lane >> 5); float w = W[(size_t)(k0 + kk) * N + src0 + (lane & 31)]; if (gain) w *= gain[k0 + kk]; scr[kk * 33 + (lane & 31)] = w; }
    asm volatile("s_waitcnt lgkmcnt(0)" ::: "memory");
    const int c = lane & 7;
#pragma unroll
    for (int j = 0; j < 4; ++j) { const int n = (lane >> 3) + 8 * j; const LAS float* s = scr + (8 * c) * 33 + n;
        u32x4 o; o.x = cvtpk(s[0 * 33], s[1 * 33]); o.y = cvtpk(s[2 * 33], s[3 * 33]); o.z = cvtpk(s[4 * 33], s[5 * 33]); o.w = cvtpk(s[6 * 33], s[7 * 33]);
        *(u32x4*)(WT + (size_t)(n0 + n) * K + k0 + 8 * c) = o; }
    asm volatile("s_waitcnt lgkmcnt(0)" ::: "memory");
}

__device__ __forceinline__ void attn_unit(const bf16_t* PROJ, const bf16_t* VT, bf16_t* Y, const float* outg, int b, int qb, LAS float* red, int wid, int lane) {
    const int h = wid, q = lane & 31, hi = lane >> 5;
    const size_t rowq = (size_t)b * SEQ + 32 * qb + q;
    bf16x8 qf[4];
#pragma unroll
    for (int kb = 0; kb < 4; ++kb) qf[kb] = *(const bf16x8*)(PROJ + rowq * INW + 1024 + h * 64 + 16 * kb + 8 * hi);
    f32x16 o0, o1;
#pragma unroll
    for (int r = 0; r < 16; ++r) { o0[r] = 0.f; o1[r] = 0.f; }
    float carry = 0.f;
    const bf16_t* Kbase = PROJ + ((size_t)b * SEQ + q) * INW + 1536 + h * 64 + 8 * hi;
    const bf16_t* Vbase = VT + (size_t)(h * 64 + q) * M + (size_t)b * SEQ + 4 * hi;
    for (int kt = qb; kt >= 0; --kt) {
        bf16x8 kf[4];
#pragma unroll
        for (int kb = 0; kb < 4; ++kb) kf[kb] = *(const bf16x8*)(Kbase + (size_t)(32 * kt) * INW + 16 * kb);
        u32x2 vlo[2][2], vhi[2][2];
#pragma unroll
        for (int d0 = 0; d0 < 2; ++d0)
#pragma unroll
            for (int k2 = 0; k2 < 2; ++k2) { const bf16_t* p = Vbase + (size_t)(32 * d0) * M + 32 * kt + 16 * k2; vlo[d0][k2] = *(const u32x2*)p; vhi[d0][k2] = *(const u32x2*)(p + 8); }
        f32x16 z;
#pragma unroll
        for (int r = 0; r < 16; ++r) z[r] = 0.f;
#pragma unroll
        for (int kb = 0; kb < 4; ++kb) z = __builtin_amdgcn_mfma_f32_32x32x16_bf16(kf[kb], qf[kb], z, 0, 0, 0);
        const bool diag = (kt == qb);
        float l[16];
#pragma unroll
        for (int r = 0; r < 16; ++r) {
            const float zr = z[r];
            const float sp = fmaxf(zr, 0.f) + __logf(1.f + __expf(-fabsf(zr)));
            l[r] = (diag && crow(r, hi) >= q) ? 0.f : -sp;
        }
        float T[4], P[4];
#pragma unroll
        for (int a = 0; a < 4; ++a) { l[4 * a + 2] += l[4 * a + 3]; l[4 * a + 1] += l[4 * a + 2]; l[4 * a] += l[4 * a + 1]; T[a] = l[4 * a]; }
#pragma unroll
        for (int a = 0; a < 4; ++a) P[a] = __shfl_xor(T[a], 32);
        float run = 0.f, att[16];
#pragma unroll
        for (int a = 3; a >= 0; --a) {
            const float e = carry + run + (hi == 0 ? P[a] : 0.f);
#pragma unroll
            for (int i = 0; i < 4; ++i) { const int r = 4 * a + i; const float v = __expf(z[r] + e + l[r]); att[r] = (diag && crow(r, hi) >= q) ? 0.f : v; }
            run += T[a] + P[a];
        }
        carry += run;
        u32x4 pa0, pa1;
        pa0.x = cvtpk(att[0], att[1]); pa0.y = cvtpk(att[2], att[3]); pa0.z = cvtpk(att[4], att[5]); pa0.w = cvtpk(att[6], att[7]);
        pa1.x = cvtpk(att[8], att[9]); pa1.y = cvtpk(att[10], att[11]); pa1.z = cvtpk(att[12], att[13]); pa1.w = cvtpk(att[14], att[15]);
#define VFRAG(d0, k2) __builtin_bit_cast(bf16x8, ((u32x4){vlo[d0][k2].x, vlo[d0][k2].y, vhi[d0][k2].x, vhi[d0][k2].y}))
        o0 = __builtin_amdgcn_mfma_f32_32x32x16_bf16(__builtin_bit_cast(bf16x8, pa0), VFRAG(0, 0), o0, 0, 0, 0);
        o0 = __builtin_amdgcn_mfma_f32_32x32x16_bf16(__builtin_bit_cast(bf16x8, pa1), VFRAG(0, 1), o0, 0, 0, 0);
        o1 = __builtin_amdgcn_mfma_f32_32x32x16_bf16(__builtin_bit_cast(bf16x8, pa0), VFRAG(1, 0), o1, 0, 0, 0);
        o1 = __builtin_amdgcn_mfma_f32_32x32x16_bf16(__builtin_bit_cast(bf16x8, pa1), VFRAG(1, 1), o1, 0, 0, 0);
#undef VFRAG
    }
#pragma unroll
    for (int r = 0; r < 16; ++r) {
        float v = o0[r] * o0[r] + o1[r] * o1[r];
        v += __shfl_xor(v, 1); v += __shfl_xor(v, 2); v += __shfl_xor(v, 4); v += __shfl_xor(v, 8); v += __shfl_xor(v, 16);
        if (q == 0) red[32 + wid * 32 + crow(r, hi)] = v;
    }
    __syncthreads();
    if (wid == 0 && lane < 32) { float s = 0.f;
#pragma unroll
        for (int w = 0; w < 8; ++w) s += red[32 + w * 32 + lane];
        red[lane] = s; }
    __syncthreads();
    const float g0 = outg[h * 64 + q], g1 = outg[h * 64 + 32 + q];
#pragma unroll
    for (int r = 0; r < 16; ++r) {
        const int qr = crow(r, hi);
        const float rinv = rsqrtf(red[qr] * (1.f / 512.f) + RMS_EPS);
        bf16_t* yp = Y + ((size_t)b * SEQ + 32 * qb + qr) * DM + 512 + h * 64 + q;
        yp[0] = f2bf(o0[r] * rinv * g0); yp[32] = f2bf(o1[r] * rinv * g1);
    }
    __syncthreads();
}

__device__ __forceinline__ void conv_unit(const bf16_t* PROJ, bf16_t* Y, const float* cw, const float* cb, const float* lg, const float* lb, const float* outg,
                                          int b, int ti, LAS float* hbuf, LAS float* cbuf, int wid, int lane) {
    const int tid = wid * 64 + lane, t0 = 32 * ti;
    for (int it = tid; it < 62 * 32; it += 512) {
        const int rr = it >> 5, c8 = (it & 31) * 8, t = t0 - 30 + rr;
        f32x4 h0 = {0.f, 0.f, 0.f, 0.f}, h1 = {0.f, 0.f, 0.f, 0.f};
        if (t >= 0) {
            const bf16_t* p = PROJ + ((size_t)b * SEQ + t) * INW + c8;
            const u32x4 va = *(const u32x4*)p, ga = *(const u32x4*)(p + 256);
            h0[0] = bflo(va.x) * sigmoidf_(bflo(ga.x)); h0[1] = bfhi(va.x) * sigmoidf_(bfhi(ga.x));
            h0[2] = bflo(va.y) * sigmoidf_(bflo(ga.y)); h0[3] = bfhi(va.y) * sigmoidf_(bfhi(ga.y));
            h1[0] = bflo(va.z) * sigmoidf_(bflo(ga.z)); h1[1] = bfhi(va.z) * sigmoidf_(bfhi(ga.z));
            h1[2] = bflo(va.w) * sigmoidf_(bflo(ga.w)); h1[3] = bfhi(va.w) * sigmoidf_(bfhi(ga.w));
        }
        *(LAS f32x4*)(hbuf + rr * 256 + c8) = h0; *(LAS f32x4*)(hbuf + rr * 256 + c8 + 4) = h1;
    }
    __syncthreads();
    {
        const int c = tid & 255, half = tid >> 8;
        float w[31];
#pragma unroll
        for (int j = 0; j < 31; ++j) w[j] = cw[j * 256 + c];
        float acc[16];
        const float bias = cb[c];
#pragma unroll
        for (int tt = 0; tt < 16; ++tt) acc[tt] = bias;
#pragma unroll
        for (int i = 0; i < 46; ++i) {
            const float v = hbuf[(half * 16 + i) * 256 + c];
#pragma unroll
            for (int tt = 0; tt < 16; ++tt) { const int j = i - tt; if (j >= 0 && j <= 30) acc[tt] += w[j] * v; }
        }
#pragma unroll
        for (int tt = 0; tt < 16; ++tt) cbuf[(half * 16 + tt) * 256 + c] = acc[tt];
    }
    __syncthreads();
    {
        const f32x4 gv = *(const f32x4*)(lg + 4 * lane), bv = *(const f32x4*)(lb + 4 * lane), og = *(const f32x4*)(outg + 4 * lane);
#pragma unroll
        for (int k = 0; k < 4; ++k) {
            const int tt = wid + 8 * k;
            f32x4 x = *(LAS f32x4*)(cbuf + tt * 256 + 4 * lane);
            const float mean = wave_sum((x[0] + x[1]) + (x[2] + x[3])) * (1.f / 256.f);
            x = x - mean;
            const float rstd = rsqrtf(wave_sum(dot4(x)) * (1.f / 256.f) + LN_EPS);
            f32x4 s;
#pragma unroll
            for (int j = 0; j < 4; ++j) { const float y = x[j] * rstd * gv[j] + bv[j]; s[j] = y * sigmoidf_(y); }
            const float rinv = rsqrtf(wave_sum(dot4(s)) * (1.f / 256.f) + RMS_EPS);
            u32x2 o; o.x = cvtpk(s[0] * rinv * og[0], s[1] * rinv * og[1]); o.y = cvtpk(s[2] * rinv * og[2], s[3] * rinv * og[3]);
            *(u32x2*)(Y + ((size_t)b * SEQ + t0 + tt) * DM + 4 * lane) = o;
        }
    }
    __syncthreads();
}

constexpr int VT_P = 136;
__device__ __forceinline__ void sg_unit(const bf16_t* PROJ, bf16_t* Y, const bf16_t* WSG, const float* sgb, const float* lg, const float* lb, const float* outg,
                                        int b, int n, int th, LAS bf16_t* vT, LAS float* red, int wid, int lane) {
    const int smax = 64 * (th + 1);
    const size_t row0 = (size_t)b * SEQ + 128 * n;
    {
        const f32x4 gv = *(const f32x4*)(lg + 4 * lane), bv = *(const f32x4*)(lb + 4 * lane);
        for (int s = wid; s < smax; s += 8) {
            const u32x2 raw = *(const u32x2*)(PROJ + (row0 + s) * INW + 768 + 4 * lane);
            f32x4 x = {gelu_erf(bflo(raw.x)), gelu_erf(bfhi(raw.x)), gelu_erf(bflo(raw.y)), gelu_erf(bfhi(raw.y))};
            const float mean = wave_sum((x[0] + x[1]) + (x[2] + x[3])) * (1.f / 256.f);
            x = x - mean;
            const float rstd = rsqrtf(wave_sum(dot4(x)) * (1.f / 256.f) + LN_EPS);
#pragma unroll
            for (int j = 0; j < 4; ++j) vT[(4 * lane + j) * VT_P + s] = f2bf(x[j] * rstd * gv[j] + bv[j]);
        }
    }
    __syncthreads();
    const int nt2 = wid & 1, cq = wid >> 1, t31 = lane & 31, hi = lane >> 5;
    const int tl = 64 * th + 32 * nt2 + t31;
    f32x16 acc0, acc1;
#pragma unroll
    for (int r = 0; r < 16; ++r) { acc0[r] = 0.f; acc1[r] = 0.f; }
    const int nkb = 2 * (2 * th + nt2 + 1);
    const bf16_t* wrow = WSG + ((size_t)cq * 128 + tl) * 128 + 8 * hi;
    const LAS bf16_t* a0 = vT + (64 * cq + t31) * VT_P + 8 * hi;
    for (int kb = 0; kb < nkb; ++kb) {
        const bf16x8 Bf = *(const bf16x8*)(wrow + 16 * kb);
        const bf16x8 A0 = *(const LAS bf16x8*)(a0 + 16 * kb), A1 = *(const LAS bf16x8*)(a0 + 32 * VT_P + 16 * kb);
        acc0 = __builtin_amdgcn_mfma_f32_32x32x16_bf16(A0, Bf, acc0, 0, 0, 0);
        acc1 = __builtin_amdgcn_mfma_f32_32x32x16_bf16(A1, Bf, acc1, 0, 0, 0);
    }
    const float bias = sgb[cq * 128 + tl];
    float ss = 0.f;
    const bf16_t* up = PROJ + (row0 + tl) * INW + 512 + 64 * cq + 4 * hi;
#pragma unroll
    for (int a = 0; a < 4; ++a) {
        const u32x2 r0 = *(const u32x2*)(up + 8 * a), r1 = *(const u32x2*)(up + 32 + 8 * a);
        acc0[4 * a + 0] = gelu_erf(bflo(r0.x)) * (acc0[4 * a + 0] + bias); acc0[4 * a + 1] = gelu_erf(bfhi(r0.x)) * (acc0[4 * a + 1] + bias);
        acc0[4 * a + 2] = gelu_erf(bflo(r0.y)) * (acc0[4 * a + 2] + bias); acc0[4 * a + 3] = gelu_erf(bfhi(r0.y)) * (acc0[4 * a + 3] + bias);
        acc1[4 * a + 0] = gelu_erf(bflo(r1.x)) * (acc1[4 * a + 0] + bias); acc1[4 * a + 1] = gelu_erf(bfhi(r1.x)) * (acc1[4 * a + 1] + bias);
        acc1[4 * a + 2] = gelu_erf(bflo(r1.y)) * (acc1[4 * a + 2] + bias); acc1[4 * a + 3] = gelu_erf(bfhi(r1.y)) * (acc1[4 * a + 3] + bias);
    }
#pragma unroll
    for (int r = 0; r < 16; ++r) ss += acc0[r] * acc0[r] + acc1[r] * acc1[r];
    ss += __shfl_xor(ss, 32);
    if (hi == 0) red[cq * 64 + 32 * nt2 + t31] = ss;
    __syncthreads();
    const int tloc = 32 * nt2 + t31;
    const float rinv = rsqrtf(((red[tloc] + red[64 + tloc]) + (red[128 + tloc] + red[192 + tloc])) * (1.f / 256.f) + RMS_EPS);
    bf16_t* yp = Y + (row0 + tl) * DM + 256 + 64 * cq + 4 * hi;
    const float* gp = outg + 64 * cq + 4 * hi;
#pragma unroll
    for (int a = 0; a < 4; ++a) {
        const f32x4 ga = *(const f32x4*)(gp + 8 * a), gb = *(const f32x4*)(gp + 32 + 8 * a);
        u32x2 o; o.x = cvtpk(acc0[4 * a] * rinv * ga[0], acc0[4 * a + 1] * rinv * ga[1]); o.y = cvtpk(acc0[4 * a + 2] * rinv * ga[2], acc0[4 * a + 3] * rinv * ga[3]);
        *(u32x2*)(yp + 8 * a) = o;
        u32x2 p; p.x = cvtpk(acc1[4 * a] * rinv * gb[0], acc1[4 * a + 1] * rinv * gb[1]); p.y = cvtpk(acc1[4 * a + 2] * rinv * gb[2], acc1[4 * a + 3] * rinv * gb[3]);
        *(u32x2*)(yp + 32 + 8 * a) = p;
    }
    __syncthreads();
}

#define GSYNC() xcd_barrier(bar)
struct Args { const float* in[18]; float* out; unsigned char* ws; };
__global__ void __launch_bounds__(512, 2) mega_fwd(Args a) {
    extern __shared__ __attribute__((aligned(16))) unsigned char lds_raw[];
    LAS unsigned char* lds = (LAS unsigned char*)lds_raw;
    const int tid = threadIdx.x, lane = tid & 63, wid = __builtin_amdgcn_readfirstlane(tid >> 6);
    const int G = gridDim.x, bx = blockIdx.x, gw = bx * 8 + wid, NGW = G * 8;
    unsigned char* ws = a.ws;
    const float* x_in = a.in[0];
    float* SSA = (float*)(ws + WS_SS); float* SSB = (float*)(ws + WS_SSB);
    bf16_t* WSG = (bf16_t*)(ws + WS_WSG);
    bf16_t* XB = (bf16_t*)(ws + WS_XB); bf16_t* Yb = (bf16_t*)(ws + WS_Y); bf16_t* PROJ = (bf16_t*)(ws + WS_PROJ); bf16_t* VT = (bf16_t*)(ws + WS_VT); bf16_t* Hb = (bf16_t*)(ws + WS_H);
    float* out = a.out;
    volatile LAS unsigned* bst = (volatile LAS unsigned*)(lds + LDS_BYTES - 16);
    if (tid < 4) bst[tid] = 0u;
    __syncthreads();
    XcdBarrier bar = xcd_barrier_post((unsigned*)(ws + WS_BAR), bst);
    if (a.ws == nullptr) cg::this_grid().sync();

    {
        LAS float* scr = (LAS float*)(lds + wid * 8448);
        for (int it = gw; it < DEPTH * 6016; it += NGW) {
            const int l = it / 6016; int r = it - l * 6016;
            bf16_t* wl = (bf16_t*)(ws + WS_W + (size_t)l * W_LAYER);
            if (r < 1280) { const int kb = r / 80, nb = r - kb * 80, n0 = 32 * nb, pn = n0 >> 8, p = n0 & 255, bj = p >> 7, wc = (p >> 5) & 3;
                transpose_item(a.in[2] + (size_t)l * DM * INW, DM, INW, wl + WOFF_IN / 2, a.in[1] + l * DM, scr, kb, n0, 256 * pn + 64 * wc + 32 * bj, lane); }
            else if (r < 1792) { r -= 1280; const int kb = r >> 5, nb = r & 31;
                transpose_item(a.in[14] + (size_t)l * DM * DM, DM, DM, wl + WOFF_OUT / 2, nullptr, scr, kb, 32 * nb, 32 * nb, lane); }
            else if (r < 4608) { r -= 1792; const int kb = r / 176, nb = r - kb * 176, n0 = 32 * nb, pn = n0 >> 8, p = n0 & 255, bj = p >> 7, q = (p >> 5) & 3;
                transpose_item(a.in[16] + (size_t)l * DM * GUW, DM, GUW, wl + WOFF_GU / 2, a.in[15] + l * DM, scr, kb, n0, (bj ? FFH : 0) + 128 * pn + 32 * q, lane); }
            else { r -= 4608; const int kb = r >> 5, nb = r & 31;
                transpose_item(a.in[17] + (size_t)l * FFH * DM, FFH, DM, wl + WOFF_DN / 2, nullptr, scr, kb, 32 * nb, 32 * nb, lane); }
        }
        for (int m = gw; m < M; m += NGW) {
            const f32x4* xr = (const f32x4*)(x_in + (size_t)m * DM) + lane; float s = 0.f;
            u32x2* o = (u32x2*)(XB + (size_t)m * DM) + lane;
#pragma unroll
            for (int j = 0; j < 4; ++j) { const f32x4 v = xr[64 * j]; s += dot4(v); u32x2 w; w.x = cvtpk(v[0], v[1]); w.y = cvtpk(v[2], v[3]); o[64 * j] = w; }
            s = wave_sum(s); if (lane < 16) SSB[(size_t)m * 16 + lane] = lane == 0 ? s : 0.f;
        }
        for (int i = bx * 512 + tid; i < DEPTH * 4 * 128 * 128; i += G * 512) { const int s = i & 127, t = (i >> 7) & 127; WSG[i] = f2bf(s <= t ? a.in[9][i] : 0.f); }
    }
    GSYNC();

    for (int l = 0; l < DEPTH; ++l) {
        const bf16_t* wl = (const bf16_t*)(ws + WS_W + (size_t)l * W_LAYER);
        { pg8::Gemm g{XB, wl + WOFF_IN / 2, M, INW, DM}; pg8::StaticOrder S; S.init(M, INW, G, bx);
          EpiInProj E{PROJ, VT, SSB, a.in[11] + l * 64, a.in[12] + l * 64};
          pg8::gemm_phase<EpiInProj, pg8::StaticOrder, true, true>(lds, g, S, E); }
        GSYNC();
        {
            const float* outg = a.in[13] + l * DM;
            int lane_l = threadIdx.x & 63; asm volatile("" : "+v"(lane_l)); const int lane = lane_l;
#ifdef DIAG_FILL
            for (size_t i = (size_t)bx * 512 + threadIdx.x; i < (size_t)M * DM / 8; i += (size_t)G * 512) { const size_t r = i >> 7, c = (i & 127) * 8; *(u32x4*)(Yb + r * DM + c) = *(const u32x4*)(PROJ + r * INW + c); }
            GSYNC();
#endif
#ifndef DIAG_NOATTN
            for (int p = bx; p < 256; p += G) {
                const int b = p & 7, s = p >> 3;
                attn_unit(PROJ, VT, Yb, outg + 512, b, s, (LAS float*)lds, wid, lane);
                attn_unit(PROJ, VT, Yb, outg + 512, b, 63 - s, (LAS float*)lds, wid, lane);
            }
#endif
#ifndef DIAG_NOCONV
            for (int id = bx; id < 512; id += G)
                conv_unit(PROJ, Yb, a.in[3] + l * 31 * 256, a.in[4] + l * 256, a.in[5] + l * 256, a.in[6] + l * 256, outg, id & 7, (id >> 3) & 63, (LAS float*)lds, (LAS float*)(lds + 63488), wid, lane);
#endif
#ifndef DIAG_NOSG
            for (int id = bx; id < 256; id += G)
                sg_unit(PROJ, Yb, WSG + (size_t)l * 4 * 128 * 128, a.in[10] + l * 512, a.in[7] + l * 256, a.in[8] + l * 256, outg + 256, id & 7, (id >> 4) & 15, (id >> 3) & 1,
                        (LAS bf16_t*)lds, (LAS float*)(lds + 69632), wid, lane);
#endif
        }
        GSYNC();
        { pg8::Gemm g{Yb, wl + WOFF_OUT / 2, M, DM, DM}; pg8::StaticOrder S; S.init(M, DM, G, bx);
          EpiRes E{l == 0 ? x_in : out, out, XB, SSA};
          pg8::gemm_phase<EpiRes, pg8::StaticOrder, true, true>(lds, g, S, E); }
        GSYNC();
        { pg8::Gemm g{XB, wl + WOFF_GU / 2, M, GUW, DM}; pg8::StaticOrder S; S.init(M, GUW, G, bx);
          EpiSwiglu E{Hb, SSA};
          pg8::gemm_phase<EpiSwiglu, pg8::StaticOrder, true, true>(lds, g, S, E); }
        GSYNC();
        { pg8::Gemm g{Hb, wl + WOFF_DN / 2, M, DM, FFH}; pg8::StaticOrder S; S.init(M, DM, G, bx);
          const bool last = (l == DEPTH - 1);
          EpiRes E{out, out, last ? nullptr : XB, last ? nullptr : SSB};
          pg8::gemm_phase<EpiRes, pg8::StaticOrder, true, true>(lds, g, S, E); }
        if (l + 1 < DEPTH) GSYNC();
    }
}

extern "C" void kernel_launch(void* const* d_in, const int* in_sizes, int n_in, void* d_out, int out_size, void* d_ws, size_t ws_size, hipStream_t stream) {
    static int grid = 0;
    if (grid == 0) {
        if (n_in != 18 || in_sizes[0] != M * DM || out_size != M * DM || ws_size < WS_END) { fprintf(stderr, "kernel_launch: unexpected shapes (n_in %d, in0 %d, out %d, ws %zu)\n", n_in, n_in > 0 ? in_sizes[0] : -1, out_size, ws_size); grid = -1; return; }
        int dev = 0, cus = 0, per_cu = 0;
        if (hipGetDevice(&dev) != hipSuccess || hipDeviceGetAttribute(&cus, hipDeviceAttributeMultiprocessorCount, dev) != hipSuccess) { grid = -1; return; }
        if (hipFuncSetAttribute((const void*)mega_fwd, hipFuncAttributeMaxDynamicSharedMemorySize, LDS_BYTES) != hipSuccess) { fprintf(stderr, "kernel_launch: hipFuncSetAttribute failed\n"); grid = -1; return; }
        if (hipOccupancyMaxActiveBlocksPerMultiprocessor(&per_cu, (const void*)mega_fwd, 512, LDS_BYTES) != hipSuccess || per_cu < 1) { fprintf(stderr, "kernel_launch: occupancy query gave %d\n", per_cu); per_cu = 1; }
        (void)hipGetLastError();
        grid = cus * per_cu;
        fprintf(stderr, "kernel_launch: grid %d (%d CUs x %d)\n", grid, cus, per_cu);
    }
    if (grid < 0) return;
    if (hipMemsetAsync((char*)d_ws + WS_BAR, 0, BAR_BYTES, stream) != hipSuccess) { fprintf(stderr, "kernel_launch: memset failed\n"); return; }
    Args a{};
    for (int i = 0; i < 18; ++i) a.in[i] = (const float*)d_in[i];
    a.out = (float*)d_out; a.ws = (unsigned char*)d_ws;
    void* args[] = {&a};
    hipError_t e = hipLaunchCooperativeKernel((const void*)mega_fwd, dim3(grid), dim3(512), args, LDS_BYTES, stream);
    if (e != hipSuccess) fprintf(stderr, "kernel_launch: cooperative launch failed: %s (grid %d)\n", hipGetErrorString(e), grid);
}
```

```cpp
#include <hip/hip_runtime.h>
#include <hip/hip_cooperative_groups.h>
#include <cstdio>
#include <cstdint>
namespace cg = cooperative_groups;
namespace pg8 {
#define PG8_LAS __attribute__((address_space(3)))
typedef unsigned short bf16_t;
typedef short bf16x8 __attribute__((ext_vector_type(8)));
typedef float f32x4 __attribute__((ext_vector_type(4)));
typedef unsigned u32x4 __attribute__((ext_vector_type(4)));
constexpr int BM = 256, BK = 64, HALF = 128, HTB = HALF * BK * 2  , STAGE_BYTES = 8 * HTB, NXCD = 8, WGM = 8;

__host__ __device__ __forceinline__ int lds_byte(int r, int c) { const int st = (r >> 4) * 2 + (c >> 5), rr = r & 15, cc = c & 31, ob = rr * 64 + cc * 2; return st * 1024 + (ob ^ (((ob >> 9) & 1) << 5)); }
__host__ __device__ __forceinline__ void stage_rc(int b, int& R, int& C) { const int st = b / 1024, sb = b % 1024, swz = sb ^ (((sb >> 9) & 1) << 5); R = (st >> 1) * 16 + swz / 64; C = (st & 1) * 32 + (swz % 64) / 2; }
__host__ __device__ __forceinline__ int perm32(int rho) { const int n = rho >> 4, i = rho & 15; return 8 * (i >> 2) + 4 * n + (i & 3); }

struct Unit { int pm, pn; };
struct Gemm { const bf16_t* A; const bf16_t* Bt; int M, N, K; };

struct StaticOrder {
    int nM, nN, nwg, G, c;
    __host__ __device__ void init(int M, int N, int G_, int c_) { nM = M / BM; nN = N / BM; nwg = nM * nN; G = G_; c = c_; }
    __host__ __device__ bool next(int i, Unit& u) const {
        const long L = (long)i * G + c; if (L >= nwg) return false;
        int wgid = (int)L; { const int q = nwg / NXCD, r = nwg % NXCD, xcd = wgid % NXCD, off = wgid / NXCD; wgid = (xcd < r ? xcd * (q + 1) : r * (q + 1) + (xcd - r) * q) + off; }
        const int nig = WGM * nN, gid = wgid / nig, fm = gid * WGM, gsz = (nM - fm) < WGM ? (nM - fm) : WGM;
        u.pm = fm + ((wgid % nig) % gsz); u.pn = (wgid % nig) / gsz; return true;
    }
    __device__ __forceinline__ void a_ready(const Unit&) const {}
    __device__ __forceinline__ void done(const Unit&) const {}
};

__device__ __forceinline__ unsigned cvt_pk_bf16(float lo, float hi) { unsigned r; asm volatile("v_cvt_pk_bf16_f32 %0, %1, %2" : "=v"(r) : "v"(lo), "v"(hi)); return r; }
typedef float f32x2 __attribute__((ext_vector_type(2)));
template <class Epi, class Sched, bool ALIGN_EPI = false, bool SP2 = false>
__device__ __forceinline__ void gemm_phase(PG8_LAS unsigned char* lds, const Gemm g, const Sched& S, const Epi& E) {
    int tid_l = threadIdx.x; asm volatile("" : "+v"(tid_l)); const int tid = tid_l, wid = __builtin_amdgcn_readfirstlane(tid >> 6), lane = tid & 63, wr = wid >> 2, wc = wid & 3, fr = lane & 15, fq = lane >> 4;
    const int K = g.K, nt = K / BK;
    unsigned voffA[2], voffB[2];
#pragma unroll
    for (int i = 0; i < 2; ++i) { int R, C; stage_rc(tid * 16 + i * 8192, R, C); const int Rb = Epi::PERM ? ((R & ~31) + perm32(R & 31)) : R;
        voffA[i] = (unsigned)(R * K + C) * 2u; voffB[i] = (unsigned)(Rb * K + C) * 2u; }
    const size_t kstep = (size_t)(BK * 2);
    const size_t hstep = (size_t)HALF * K * 2;
    const size_t tstep = 2 * hstep;
    const unsigned ldsw = (unsigned)wid * 1024u;
    const int aoff = lds_byte(wr * 64 + fr, fq * 8), boff = lds_byte(wc * 32 + fr, fq * 8);
#define PG8_SA(b, h) (((b) * 2 + (h)) * HTB)
#define PG8_SB(b, h) ((4 + (b) * 2 + (h)) * HTB)
#define PG8_STAGE(bufoff, gbase, voff) do { _Pragma("unroll") for (int _i = 0; _i < 2; ++_i) \
        __builtin_amdgcn_global_load_lds((const unsigned*)((const char*)(gbase) + (voff)[_i]), (PG8_LAS unsigned*)(lds + (bufoff) + ldsw + _i * 8192), 16, 0, 0); } while (0)
#define PG8_LDA(dst, b, h) do { _Pragma("unroll") for (int m = 0; m < 4; ++m) _Pragma("unroll") for (int k = 0; k < 2; ++k) dst[m][k] = *(const PG8_LAS bf16x8*)(lds + PG8_SA(b, h) + aoff + m * 2048 + k * 1024); } while (0)
#define PG8_LDB(dst, b, h) do { _Pragma("unroll") for (int n = 0; n < 2; ++n) _Pragma("unroll") for (int k = 0; k < 2; ++k) dst[n][k] = *(const PG8_LAS bf16x8*)(lds + PG8_SB(b, h) + boff + n * 2048 + k * 1024); } while (0)
#define PG8_MMA(ai, bj, At, Bt) do { __builtin_amdgcn_s_setprio(1); _Pragma("unroll") for (int m = 0; m < 4; ++m) _Pragma("unroll") for (int n = 0; n < 2; ++n) _Pragma("unroll") for (int k = 0; k < 2; ++k) \
        acc[ai][bj][m][n] = __builtin_amdgcn_mfma_f32_16x16x32_bf16(Bt[n][k], At[m][k], acc[ai][bj][m][n], 0, 0, 0); __builtin_amdgcn_s_setprio(0); } while (0)
#define PG8_WAIT_V(n) asm volatile("s_waitcnt vmcnt(" #n ")" ::: "memory")
#define PG8_WAIT_L(n) asm volatile("s_waitcnt lgkmcnt(" #n ")" ::: "memory")
#define PG8_BAR __builtin_amdgcn_s_barrier()
#define PG8_SCHED __builtin_amdgcn_sched_barrier(0)
    Unit cur, nxt; int ui = 0;
    if (!S.next(0, cur)) return;
    f32x4 acc[2][2][4][2];
#pragma unroll
    for (int a = 0; a < 2; ++a)
#pragma unroll
        for (int b = 0; b < 2; ++b)
#pragma unroll
            for (int m = 0; m < 4; ++m)
#pragma unroll
                for (int n = 0; n < 2; ++n) acc[a][b][m][n] = (f32x4){0.f, 0.f, 0.f, 0.f};
    bf16x8 At[4][2], B0[2][2], B1[2][2];
    const char* cA = (const char*)g.A + (size_t)cur.pm * tstep; const char* cB = (const char*)g.Bt + (size_t)cur.pn * tstep;
    S.a_ready(cur);
    if constexpr (SP2) {
        PG8_STAGE(PG8_SB(0, 0), cB, voffB); PG8_STAGE(PG8_SB(0, 1), cB + hstep, voffB); PG8_STAGE(PG8_SA(0, 0), cA, voffA); PG8_STAGE(PG8_SA(0, 1), cA + hstep, voffA);
        if (wr == 1) PG8_BAR;
        PG8_WAIT_V(2); PG8_BAR;
        PG8_STAGE(PG8_SB(1, 0), cB + kstep, voffB); PG8_STAGE(PG8_SA(1, 0), cA + kstep, voffA); PG8_STAGE(PG8_SB(1, 1), cB + hstep + kstep, voffB);
        PG8_WAIT_V(6); PG8_BAR;
    } else {
        PG8_STAGE(PG8_SB(0, 0), cB, voffB); PG8_STAGE(PG8_SA(0, 0), cA, voffA); PG8_STAGE(PG8_SB(0, 1), cB + hstep, voffB); PG8_STAGE(PG8_SA(0, 1), cA + hstep, voffA);
        if (wr == 1) PG8_BAR;
        PG8_WAIT_V(4); PG8_BAR;
        PG8_STAGE(PG8_SB(1, 0), cB + kstep, voffB); PG8_STAGE(PG8_SA(1, 0), cA + kstep, voffA); PG8_STAGE(PG8_SB(1, 1), cB + hstep + kstep, voffB);
        PG8_WAIT_V(6); PG8_BAR;
    }
    for (;;) {
        const bool has_next = S.next(ui + 1, nxt);
        const char* nA = has_next ? (const char*)g.A + (size_t)nxt.pm * tstep : cA; const char* nB = has_next ? (const char*)g.Bt + (size_t)nxt.pn * tstep : cB;
        asm volatile(".p2align 6");
        for (int t = 0; t < nt; t += 2) {
            const bool last = (t == nt - 2);
            const char* a1 = cA + (size_t)(t + 1) * kstep;
            const char* a2 = last ? nA : cA + (size_t)(t + 2) * kstep; const char* b2 = last ? nB : cB + (size_t)(t + 2) * kstep;
            const char* a3 = a2 + kstep; const char* b3 = b2 + kstep;
            if (last && has_next) S.a_ready(nxt);
            if constexpr (SP2) {
            PG8_LDB(B0, 0, 0); PG8_LDB(B1, 0, 1); PG8_SCHED; PG8_LDA(At, 0, 0); PG8_STAGE(PG8_SA(1, 1), a1 + hstep, voffA);
            PG8_WAIT_V(8); PG8_WAIT_L(0); PG8_BAR; PG8_MMA(0, 0, At, B0); PG8_MMA(0, 1, At, B1); PG8_BAR; PG8_SCHED;
            PG8_LDA(At, 0, 1); PG8_STAGE(PG8_SB(0, 0), b2, voffB); PG8_STAGE(PG8_SB(0, 1), b2 + hstep, voffB); PG8_STAGE(PG8_SA(0, 0), a2, voffA);
            PG8_WAIT_V(8); PG8_WAIT_L(0); PG8_BAR; PG8_MMA(1, 0, At, B0); PG8_MMA(1, 1, At, B1); PG8_BAR; PG8_SCHED;
            PG8_LDB(B0, 1, 0); PG8_LDB(B1, 1, 1); PG8_SCHED; PG8_LDA(At, 1, 0); PG8_STAGE(PG8_SA(0, 1), a2 + hstep, voffA);
            PG8_WAIT_V(8); PG8_WAIT_L(0); PG8_BAR; PG8_MMA(0, 0, At, B0); PG8_MMA(0, 1, At, B1); PG8_BAR; PG8_SCHED;
            PG8_LDA(At, 1, 1); PG8_STAGE(PG8_SB(1, 0), b3, voffB); PG8_STAGE(PG8_SB(1, 1), b3 + hstep, voffB); PG8_STAGE(PG8_SA(1, 0), a3, voffA);
            PG8_WAIT_V(8); PG8_WAIT_L(0); PG8_BAR; PG8_MMA(1, 0, At, B0); PG8_MMA(1, 1, At, B1); PG8_BAR; PG8_SCHED;
            } else {
            PG8_LDB(B0, 0, 0); PG8_SCHED; PG8_LDA(At, 0, 0); PG8_STAGE(PG8_SA(1, 1), a1 + hstep, voffA);
            PG8_WAIT_L(8); PG8_BAR; PG8_WAIT_L(0); PG8_MMA(0, 0, At, B0); PG8_BAR; PG8_SCHED;
            PG8_LDB(B1, 0, 1); PG8_STAGE(PG8_SB(0, 0), b2, voffB);
            PG8_BAR; PG8_WAIT_L(0); PG8_MMA(0, 1, At, B1); PG8_BAR;
            PG8_LDA(At, 0, 1); PG8_STAGE(PG8_SA(0, 0), a2, voffA);
            PG8_BAR; PG8_WAIT_L(0); PG8_MMA(1, 0, At, B0); PG8_BAR; PG8_SCHED;
            PG8_STAGE(PG8_SB(0, 1), b2 + hstep, voffB);
            PG8_WAIT_V(6); PG8_BAR; PG8_MMA(1, 1, At, B1); PG8_BAR;
            PG8_LDB(B0, 1, 0); PG8_SCHED; PG8_LDA(At, 1, 0); PG8_STAGE(PG8_SA(0, 1), a2 + hstep, voffA);
            PG8_WAIT_L(8); PG8_BAR; PG8_WAIT_L(0); PG8_MMA(0, 0, At, B0); PG8_BAR; PG8_SCHED;
            PG8_LDB(B1, 1, 1); PG8_STAGE(PG8_SB(1, 0), b3, voffB);
            PG8_BAR; PG8_WAIT_L(0); PG8_MMA(0, 1, At, B1); PG8_BAR;
            PG8_LDA(At, 1, 1); PG8_STAGE(PG8_SA(1, 0), a3, voffA);
            PG8_BAR; PG8_WAIT_L(0); PG8_MMA(1, 0, At, B0); PG8_BAR; PG8_SCHED;
            PG8_STAGE(PG8_SB(1, 1), b3 + hstep, voffB);
            PG8_WAIT_V(6); PG8_BAR; PG8_MMA(1, 1, At, B1); PG8_BAR;
            }
        }
        if constexpr (ALIGN_EPI) { if (wr == 0) PG8_BAR; }
        if constexpr (!Epi::AFTER_DRAIN) { E(acc, cur, wr, wc, fr, fq); S.done(cur); }
        if (!has_next) break;
#pragma unroll
        for (int a = 0; a < 2; ++a)
#pragma unroll
            for (int b = 0; b < 2; ++b)
#pragma unroll
                for (int m = 0; m < 4; ++m)
#pragma unroll
                    for (int n = 0; n < 2; ++n) acc[a][b][m][n] = (f32x4){0.f, 0.f, 0.f, 0.f};
        cur = nxt; cA = nA; cB = nB; ++ui;
        if constexpr (ALIGN_EPI) { if (wr == 1) PG8_BAR; }
    }
    PG8_WAIT_V(0);
    if constexpr (!ALIGN_EPI) { if (wr == 0) PG8_BAR; }
    PG8_BAR;
    if constexpr (Epi::AFTER_DRAIN) { E.fused(acc, cur, wr, wc, fr, fq, lds, wid, lane); S.done(cur); }
#undef PG8_SA
#undef PG8_SB
#undef PG8_STAGE
#undef PG8_LDA
#undef PG8_LDB
#undef PG8_MMA
#undef PG8_WAIT_V
#undef PG8_WAIT_L
#undef PG8_BAR
#undef PG8_SCHED
}
}
#define GAS __attribute__((address_space(1)))
#define LAS __attribute__((address_space(3)))
#define RLX_AGENT __ATOMIC_RELAXED, __HIP_MEMORY_SCOPE_AGENT
#define LDS_WAIT() asm volatile("s_waitcnt lgkmcnt(0)" ::: "memory")
#define VM_WAIT() asm volatile("s_waitcnt vmcnt(0)" ::: "memory")
__device__ __forceinline__ unsigned long long rt() { return __builtin_amdgcn_s_memrealtime(); }
#define XB_TMO      128
#define XB_XCNT(j)  (256  + 64 * (j))
#define XB_XSUB(j)  (1280 + 64 * (j))
#define XB_XGEN(j)  (2304 + 64 * (j))
#define XB_TOP      3328
#define XB_TOPGEN   3392
#define XCD_BAR_WORDS 3456
#define XB_SPIN_CAP (1u << 18)

__device__ __forceinline__ unsigned xb_ld(unsigned* p)              { return __hip_atomic_load(p, __ATOMIC_RELAXED, __HIP_MEMORY_SCOPE_AGENT); }
__device__ __forceinline__ unsigned xb_add(unsigned* p, unsigned v) { return __hip_atomic_fetch_add(p, v, __ATOMIC_RELAXED, __HIP_MEMORY_SCOPE_AGENT); }
__device__ __forceinline__ unsigned xb_xcc_id() { return (unsigned)__builtin_amdgcn_s_getreg((3 << 11) | 20) & 0xFu; }
#define XB_SPIN(cond, bar) do { unsigned _sp = 0; while (cond) { __builtin_amdgcn_s_sleep(1); \
    if ((++_sp & 255u) == 0u) { if (xb_ld(&(bar)[XB_TMO])) break; if (_sp > XB_SPIN_CAP) { atomicAdd(&(bar)[XB_TMO], 1u); break; } } } } while (0)

struct XcdBarrier {
    unsigned* bar; unsigned x;
    volatile LAS unsigned* st;
};

__device__ __forceinline__ XcdBarrier xcd_barrier_post(unsigned* bar, volatile LAS unsigned* st) {
    XcdBarrier b; b.bar = bar; b.x = xb_xcc_id(); b.st = st;
    if (threadIdx.x == 0) (void)xb_add(&bar[XB_XCNT(b.x)], 1u);
    return b;
}
__device__ __forceinline__ void xcd_barrier_complete(unsigned* bar, unsigned x, unsigned& nloc, unsigned& nx) {
    const unsigned G = gridDim.x * gridDim.y * gridDim.z;
    unsigned sum, cnt, mine, sp = 0u;
    for (;;) {
        sum = 0u; cnt = 0u; mine = 0u;
#pragma unroll
        for (unsigned j = 0; j < 16; ++j) { const unsigned c = xb_ld(&bar[XB_XCNT(j)]); sum += c; cnt += (c > 0u) ? 1u : 0u; mine = (j == x) ? c : mine; }
        if (sum == G) break;
        __builtin_amdgcn_s_sleep(1);
        if ((++sp & 255u) == 0u) { if (xb_ld(&bar[XB_TMO])) break; if (sp > XB_SPIN_CAP) { atomicAdd(&bar[XB_TMO], 1u); break; } }
    }
    nloc = mine > 0u ? mine : 1u; nx = cnt > 0u ? cnt : 1u;
}

__device__ __forceinline__ void xcd_barrier(const XcdBarrier& b) {
    asm volatile("s_waitcnt vmcnt(0)" ::: "memory");
    __syncthreads();
    if (threadIdx.x == 0) {
        unsigned* bar = b.bar;
        unsigned bx_ = b.x; asm volatile("" : "+s"(bx_));
        __builtin_amdgcn_s_waitcnt(0);
        unsigned nloc = b.st[0], nx = b.st[1];
        if (nloc == 0u) { xcd_barrier_complete(bar, bx_, nloc, nx); b.st[0] = nloc; b.st[1] = nx; }
        const unsigned old = xb_add(&bar[XB_XSUB(bx_)], 1u);
        const unsigned gen = old / nloc;
        if (old + 1u == (gen + 1u) * nloc) {
            __builtin_amdgcn_fence(__ATOMIC_RELEASE, "agent");
            asm volatile("s_waitcnt vmcnt(0)" ::: "memory");
            const unsigned og = xb_add(&bar[XB_TOP], 1u);
            const unsigned tg = og / nx;
            if (og + 1u == (tg + 1u) * nx) xb_add(&bar[XB_TOPGEN], 1u);
            else XB_SPIN(xb_ld(&bar[XB_TOPGEN]) == tg, bar);
            __builtin_amdgcn_fence(__ATOMIC_ACQUIRE, "agent");
            xb_add(&bar[XB_XGEN(bx_)], 1u);
            asm volatile("s_waitcnt vmcnt(0)" ::: "memory");
        } else {
            XB_SPIN(xb_ld(&bar[XB_XGEN(bx_)]) == gen, bar);
            __builtin_amdgcn_fence(__ATOMIC_ACQUIRE, "agent");
            asm volatile("s_waitcnt vmcnt(0)" ::: "memory");
        }
    }
    __syncthreads();
}
typedef unsigned short bf16_t;
typedef short bf16x8 __attribute__((ext_vector_type(8)));
typedef float f32x4 __attribute__((ext_vector_type(4)));
typedef float f32x16 __attribute__((ext_vector_type(16)));
typedef unsigned u32x4 __attribute__((ext_vector_type(4)));
typedef unsigned u32x2 __attribute__((ext_vector_type(2)));

constexpr int DM = 1024, NB = 8, SEQ = 2048, DEPTH = 4, M = NB * SEQ, INW = 2560, FFH = 2816, GUW = 5632;
constexpr float RMS_EPS = 1e-6f, LN_EPS = 1e-5f;
constexpr size_t MiB = 1u << 20;
constexpr size_t WS_SS = 0;
constexpr size_t WS_SSB = 256 * MiB;
constexpr size_t WS_BAR = 1536 * 1024, BAR_BYTES = 16384;
constexpr size_t WS_WSG = 1 * MiB;
constexpr size_t WS_W = 2 * MiB;
constexpr size_t W_LAYER = 47 * MiB / 2;
constexpr size_t WOFF_IN = 0, WOFF_OUT = 5 * MiB, WOFF_GU = 7 * MiB, WOFF_DN = 18 * MiB;
constexpr size_t WS_XB = 96 * MiB, WS_Y = 128 * MiB, WS_PROJ = 160 * MiB, WS_VT = 240 * MiB, WS_H = 160 * MiB, WS_END = 257 * MiB;
constexpr int LDS_BYTES = 135168;

__device__ __forceinline__ unsigned cvtpk(float lo, float hi) { typedef float f2 __attribute__((ext_vector_type(2))); typedef __bf16 b2 __attribute__((ext_vector_type(2))); f2 v = {lo, hi}; b2 b = __builtin_convertvector(v, b2); return __builtin_bit_cast(unsigned, b); }
__device__ __forceinline__ bf16_t f2bf(float f) { return (bf16_t)(cvtpk(f, 0.f) & 0xffffu); }
__device__ __forceinline__ float bf2f(unsigned short b) { return __uint_as_float((unsigned)b << 16); }
__device__ __forceinline__ float bflo(unsigned w) { return __uint_as_float(w << 16); }
__device__ __forceinline__ float bfhi(unsigned w) { return __uint_as_float(w & 0xffff0000u); }
__device__ __forceinline__ u32x4 pack8(f32x4 a, f32x4 b) { u32x4 w; w.x = cvtpk(a[0], a[1]); w.y = cvtpk(a[2], a[3]); w.z = cvtpk(b[0], b[1]); w.w = cvtpk(b[2], b[3]); return w; }
__device__ __forceinline__ float dot4(f32x4 a) { return (a[0] * a[0] + a[1] * a[1]) + (a[2] * a[2] + a[3] * a[3]); }
__device__ __forceinline__ float sigmoidf_(float x) { return __builtin_amdgcn_rcpf(1.f + __builtin_amdgcn_exp2f(x * -1.44269504089f)); }
__device__ __forceinline__ float gelu_erf(float v) {
    const float av = fabsf(v), t = __builtin_amdgcn_rcpf(av * 0.2316418882f + 1.0f);
    float q = t * 0.5307027145f + (-0.7265760135f); q = q * t + 0.7107068705f; q = q * t + (-0.142248368f); q = q * t + 0.127414796f; q = q * t;
    const float e = __builtin_amdgcn_exp2f((v * v) * (-0.72134752044f));
    const float m = v * (q * e);
    return v < 0.f ? m : v - m;
}
__device__ __forceinline__ void wave_sum_n8(float (&v)[8]) {
#pragma unroll
    for (int o = 1; o < 64; o <<= 1) { float t[8];
#pragma unroll
        for (int i = 0; i < 8; ++i) t[i] = __shfl_xor(v[i], o);
#pragma unroll
        for (int i = 0; i < 8; ++i) v[i] += t[i]; }
}
__device__ __forceinline__ void wave_sum_n4(float (&v)[4]) {
#pragma unroll
    for (int o = 1; o < 64; o <<= 1) { float t[4];
#pragma unroll
        for (int i = 0; i < 4; ++i) t[i] = __shfl_xor(v[i], o);
#pragma unroll
        for (int i = 0; i < 4; ++i) v[i] += t[i]; }
}
__device__ __forceinline__ void wave_sum2(float& a, float& b) {
#pragma unroll
    for (int o = 1; o < 64; o <<= 1) { const float ta = __shfl_xor(a, o), tb = __shfl_xor(b, o); a += ta; b += tb; }
}
__device__ __forceinline__ float wave_sum(float v) {
#pragma unroll
    for (int o = 1; o < 64; o <<= 1) v += __shfl_xor(v, o);
    return v;
}
__device__ __forceinline__ float row_rinv(const float* SS, int row) { const f32x4* p = (const f32x4*)(SS + (size_t)row * 16); const f32x4 a = p[0], b = p[1], c = p[2], d = p[3];
    const float s = ((a[0] + a[1]) + (a[2] + a[3])) + ((b[0] + b[1]) + (b[2] + b[3])) + ((c[0] + c[1]) + (c[2] + c[3])) + ((d[0] + d[1]) + (d[2] + d[3])); return rsqrtf(s * (1.f / 1024.f) + RMS_EPS); }
__device__ __forceinline__ int crow(int r, int hi) { return (r & 3) + 8 * (r >> 2) + 4 * hi; }

__host__ __device__ __forceinline__ int inproj_ltile(int pn) { return (pn == 2 || pn == 3) ? pn + 6 : ((pn == 8 || pn == 9) ? pn - 6 : pn); }
struct EpiInProj {
    static constexpr bool PERM = true, AFTER_DRAIN = false;
    bf16_t* PROJ; bf16_t* VT; const float* SS; const float* qg; const float* kg;
    __device__ __forceinline__ void operator()(const pg8::f32x4 (&acc)[2][2][4][2], const pg8::Unit& u, int wr, int wc, int fr, int fq) const {
        const int pn = inproj_ltile(u.pn);
        const int colbase = pn * 256 + 64 * wc + 8 * fq;
        f32x4 gqk[2][2];
        { const float* g = pn < 6 ? qg : kg;
#pragma unroll
          for (int bj = 0; bj < 2; ++bj)
#pragma unroll
            for (int n = 0; n < 2; ++n) gqk[bj][n] = (pn >= 4 && pn < 8) ? *(const f32x4*)(g + 32 * bj + 8 * fq + 4 * n) : (f32x4){1.f, 1.f, 1.f, 1.f}; }
        float rinvs[2][4];
        { f32x4 pv[2][4];
#pragma unroll
          for (int ai = 0; ai < 2; ++ai)
#pragma unroll
            for (int m = 0; m < 4; ++m) pv[ai][m] = *(const f32x4*)(SS + (size_t)(u.pm * 256 + ai * 128 + wr * 64 + m * 16 + fr) * 16 + 4 * fq);
#pragma unroll
          for (int ai = 0; ai < 2; ++ai)
#pragma unroll
            for (int m = 0; m < 4; ++m) { float s = (pv[ai][m][0] + pv[ai][m][1]) + (pv[ai][m][2] + pv[ai][m][3]); s += __shfl_xor(s, 16); s += __shfl_xor(s, 32); rinvs[ai][m] = rsqrtf(s * (1.f / 1024.f) + RMS_EPS); } }
#pragma unroll
        for (int ai = 0; ai < 2; ++ai)
#pragma unroll
            for (int m = 0; m < 4; ++m) {
                const int row = u.pm * 256 + ai * 128 + wr * 64 + m * 16 + fr;
                const float rinv = rinvs[ai][m];
                f32x4 v[2][2];
#pragma unroll
                for (int bj = 0; bj < 2; ++bj)
#pragma unroll
                    for (int n = 0; n < 2; ++n) v[bj][n] = acc[ai][bj][m][n] * rinv;
                if (pn >= 4 && pn < 8) {
                    float ss = (dot4(v[0][0]) + dot4(v[0][1])) + (dot4(v[1][0]) + dot4(v[1][1]));
                    ss += __shfl_xor(ss, 16); ss += __shfl_xor(ss, 32);
                    const float hr = rsqrtf(ss * (1.f / 64.f) + RMS_EPS) * (pn < 6 ? 0.125f * 1.44269504089f : 1.f);
#pragma unroll
                    for (int bj = 0; bj < 2; ++bj)
#pragma unroll
                        for (int n = 0; n < 2; ++n) v[bj][n] = v[bj][n] * gqk[bj][n] * hr;
                }
                if (pn < 8) {
#pragma unroll
                    for (int bj = 0; bj < 2; ++bj) *(u32x4*)(PROJ + (size_t)row * INW + colbase + 32 * bj) = pack8(v[bj][0], v[bj][1]);
                } else {
                    const int hd0 = ((pn - 8) * 4 + wc) * 64 + 8 * fq;
#pragma unroll
                    for (int bj = 0; bj < 2; ++bj)
#pragma unroll
                        for (int n = 0; n < 2; ++n)
#pragma unroll
                            for (int j = 0; j < 4; ++j) VT[(size_t)(hd0 + 32 * bj + 4 * n + j) * M + row] = f2bf(v[bj][n][j]);
                }
            }
    }
};
struct EpiRes {
    static constexpr bool PERM = true, AFTER_DRAIN = false;
    const float* base32; float* out32; bf16_t* XB; float* SSn;
    __device__ __forceinline__ void operator()(const pg8::f32x4 (&acc)[2][2][4][2], const pg8::Unit& u, int wr, int wc, int fr, int fq) const {
        const int col0 = u.pn * 256 + 32 * wc + 8 * fq;
#pragma unroll
        for (int ai = 0; ai < 2; ++ai)
#pragma unroll
            for (int mh = 0; mh < 2; ++mh) {
                const size_t off0 = (size_t)(u.pm * 256 + ai * 128 + wr * 64 + mh * 32 + fr) * DM + col0;
                f32x4 b0[2][2], b1[2][2];
                if (base32) {
#pragma unroll
                    for (int mm = 0; mm < 2; ++mm)
#pragma unroll
                        for (int bj = 0; bj < 2; ++bj) { const float* p = base32 + off0 + (size_t)mm * 16 * DM + 128 * bj;
                            b0[mm][bj] = __builtin_nontemporal_load((const f32x4*)p); b1[mm][bj] = __builtin_nontemporal_load((const f32x4*)(p + 4)); }
                } else {
                    u32x4 w[2][2];
#pragma unroll
                    for (int mm = 0; mm < 2; ++mm)
#pragma unroll
                        for (int bj = 0; bj < 2; ++bj) w[mm][bj] = *(const u32x4*)(XB + off0 + (size_t)mm * 16 * DM + 128 * bj);
#pragma unroll
                    for (int mm = 0; mm < 2; ++mm)
#pragma unroll
                        for (int bj = 0; bj < 2; ++bj) { const u32x4 x = w[mm][bj]; b0[mm][bj] = (f32x4){bflo(x.x), bfhi(x.x), bflo(x.y), bfhi(x.y)}; b1[mm][bj] = (f32x4){bflo(x.z), bfhi(x.z), bflo(x.w), bfhi(x.w)}; }
                }
#pragma unroll
                for (int mm = 0; mm < 2; ++mm) {
                    const int m = 2 * mh + mm;
                    const int row = u.pm * 256 + ai * 128 + wr * 64 + m * 16 + fr;
                    float ss = 0.f;
#pragma unroll
                    for (int bj = 0; bj < 2; ++bj) {
                        const size_t off = off0 + (size_t)mm * 16 * DM + 128 * bj;
                        const f32x4 v0 = b0[mm][bj] + acc[ai][bj][m][0], v1 = b1[mm][bj] + acc[ai][bj][m][1];
                        if (out32) { __builtin_nontemporal_store(v0, (f32x4*)(out32 + off)); __builtin_nontemporal_store(v1, (f32x4*)(out32 + off + 4)); }
                        else { *(u32x4*)(XB + off) = pack8(v0, v1); ss += dot4(v0) + dot4(v1); }
                    }
                    if (!out32) { ss += __shfl_xor(ss, 16); ss += __shfl_xor(ss, 32); if (fq == 0) SSn[(size_t)row * 16 + u.pn * 4 + wc] = ss; }
                }
            }
    }
};
struct EpiSwiglu {
    static constexpr bool PERM = true, AFTER_DRAIN = false;
    bf16_t* H; const float* SS;
    __device__ __forceinline__ void operator()(const pg8::f32x4 (&acc)[2][2][4][2], const pg8::Unit& u, int wr, int wc, int fr, int fq) const {
        const int col0 = u.pn * 128 + 32 * wc + 8 * fq;
        const __amdgpu_buffer_rsrc_t hrs = __builtin_amdgcn_make_buffer_rsrc(H, 0, M * FFH * 2, 0x00020000);
        float rinvs[2][4];
        { f32x4 pv[2][4];
#pragma unroll
          for (int ai = 0; ai < 2; ++ai)
#pragma unroll
            for (int m = 0; m < 4; ++m) pv[ai][m] = *(const f32x4*)(SS + (size_t)(u.pm * 256 + ai * 128 + wr * 64 + m * 16 + fr) * 16 + 4 * fq);
#pragma unroll
          for (int ai = 0; ai < 2; ++ai)
#pragma unroll
            for (int m = 0; m < 4; ++m) { float s = (pv[ai][m][0] + pv[ai][m][1]) + (pv[ai][m][2] + pv[ai][m][3]); s += __shfl_xor(s, 16); s += __shfl_xor(s, 32); rinvs[ai][m] = rsqrtf(s * (1.f / 1024.f) + RMS_EPS); } }
#pragma unroll
        for (int ai = 0; ai < 2; ++ai)
#pragma unroll
            for (int m = 0; m < 4; ++m) {
                const int row = u.pm * 256 + ai * 128 + wr * 64 + m * 16 + fr;
                const float rinv = rinvs[ai][m];
                f32x4 h[2];
#pragma unroll
                for (int n = 0; n < 2; ++n) {
                    const f32x4 g = acc[ai][0][m][n] * rinv, up = acc[ai][1][m][n] * rinv;
#pragma unroll
                    for (int j = 0; j < 4; ++j) h[n][j] = g[j] * sigmoidf_(g[j]) * up[j];
                }
                __builtin_amdgcn_raw_buffer_store_b128(pack8(h[0], h[1]), hrs, (unsigned)(((size_t)row * FFH + col0) * 2), 0,   16);
            }
    }
};

__device__ __forceinline__ void transpose_item(const float* W, int K, int N, bf16_t* WT, const float* gain, LAS float* scr, int kb, int n0, int src0, int lane) {
    const int k0 = 64 * kb;
    const float* src = W + (size_t)(k0 + (lane >> 5)) * N + src0 + (lane & 31);
    float w[32];
#pragma unroll
    for (int i = 0; i < 32; ++i) w[i] = __builtin_nontemporal_load(src + (size_t)(2 * i) * N);
    const int c = lane & 7;
    f32x4 g0 = {1.f, 1.f, 1.f, 1.f}, g1 = {1.f, 1.f, 1.f, 1.f};
    if (gain) { g0 = *(const f32x4*)(gain + k0 + 8 * c); g1 = *(const f32x4*)(gain + k0 + 8 * c + 4); }
#pragma unroll
    for (int i = 0; i < 32; ++i) scr[(2 * i + (lane >> 5)) * 33 + (lane & 31)] = w[i];
    asm volatile("s_waitcnt lgkmcnt(0)" ::: "memory");
#pragma unroll
    for (int j = 0; j < 4; ++j) { const int n = (lane >> 3) + 8 * j; const LAS float* s = scr + (8 * c) * 33 + n;
        u32x4 o; o.x = cvtpk(s[0 * 33] * g0[0], s[1 * 33] * g0[1]); o.y = cvtpk(s[2 * 33] * g0[2], s[3 * 33] * g0[3]); o.z = cvtpk(s[4 * 33] * g1[0], s[5 * 33] * g1[1]); o.w = cvtpk(s[6 * 33] * g1[2], s[7 * 33] * g1[3]);
        *(u32x4*)(WT + (size_t)(n0 + n) * K + k0 + 8 * c) = o; }
    asm volatile("s_waitcnt lgkmcnt(0)" ::: "memory");
}

__device__ __forceinline__ void sb_tile(const bf16x8 (&kf)[4], const bf16x8 (&qf)[4], const bf16x8 (&vf)[2][2], bool diag, int q, int hi, float& carry, f32x16& o0, f32x16& o1) {
    f32x16 z;
#pragma unroll
    for (int r = 0; r < 16; ++r) z[r] = 0.f;
#pragma unroll
    for (int kb = 0; kb < 4; ++kb) z = __builtin_amdgcn_mfma_f32_32x32x16_bf16(kf[kb], qf[kb], z, 0, 0, 0);
    float be[16], nb[16];
#pragma unroll
    for (int r = 0; r < 16; ++r) {
        const float zr = z[r];
        const float e = __builtin_amdgcn_exp2f(-fabsf(zr)), rr = __builtin_amdgcn_rcpf(1.f + e), er = e * rr;
        const bool msk = diag && (16 * (r >> 3) + 8 * hi + (r & 7)) >= q;
        be[r] = msk ? 0.f : (zr >= 0.f ? rr : er);
        nb[r] = msk ? 1.f : (zr >= 0.f ? er : rr);
    }
    float att[16];
#pragma unroll
    for (int g = 0; g < 2; ++g) {
        float p = 1.f;
#pragma unroll
        for (int i = 7; i >= 0; --i) { att[8 * g + i] = be[8 * g + i] * p; p *= nb[8 * g + i]; }
        nb[8 * g] = p;
    }
    const float T0 = nb[0], T1 = nb[8], P0 = __shfl_xor(T0, 32), P1 = __shfl_xor(T1, 32);
    const float run1 = T1 * P1;
    const float e1 = carry * (hi == 0 ? P1 : 1.f), e0 = carry * run1 * (hi == 0 ? P0 : 1.f);
#pragma unroll
    for (int r = 0; r < 16; ++r) att[r] *= (r < 8 ? e0 : e1);
    carry *= run1 * (T0 * P0);
    u32x4 pa0, pa1;
    pa0.x = cvtpk(att[0], att[1]); pa0.y = cvtpk(att[2], att[3]); pa0.z = cvtpk(att[4], att[5]); pa0.w = cvtpk(att[6], att[7]);
    pa1.x = cvtpk(att[8], att[9]); pa1.y = cvtpk(att[10], att[11]); pa1.z = cvtpk(att[12], att[13]); pa1.w = cvtpk(att[14], att[15]);
    o0 = __builtin_amdgcn_mfma_f32_32x32x16_bf16(vf[0][0], __builtin_bit_cast(bf16x8, pa0), o0, 0, 0, 0);
    o0 = __builtin_amdgcn_mfma_f32_32x32x16_bf16(vf[0][1], __builtin_bit_cast(bf16x8, pa1), o0, 0, 0, 0);
    o1 = __builtin_amdgcn_mfma_f32_32x32x16_bf16(vf[1][0], __builtin_bit_cast(bf16x8, pa0), o1, 0, 0, 0);
    o1 = __builtin_amdgcn_mfma_f32_32x32x16_bf16(vf[1][1], __builtin_bit_cast(bf16x8, pa1), o1, 0, 0, 0);
}
__device__ __forceinline__ void sb_stage(LAS unsigned char* wt, int r, int hi, const f32x16& o0, const f32x16& o1, float rinv) {
#pragma unroll
    for (int a = 0; a < 4; ++a) {
        u32x2 w0; w0.x = cvtpk(o0[4 * a] * rinv, o0[4 * a + 1] * rinv); w0.y = cvtpk(o0[4 * a + 2] * rinv, o0[4 * a + 3] * rinv);
        *(LAS u32x2*)(wt + r * 128 + ((a ^ (r & 7)) * 16) + 8 * hi) = w0;
        u32x2 w1; w1.x = cvtpk(o1[4 * a] * rinv, o1[4 * a + 1] * rinv); w1.y = cvtpk(o1[4 * a + 2] * rinv, o1[4 * a + 3] * rinv);
        *(LAS u32x2*)(wt + r * 128 + (((4 + a) ^ (r & 7)) * 16) + 8 * hi) = w1;
    }
}
__device__ __forceinline__ void attn_unit(const bf16_t* PROJ, const bf16_t* VT, bf16_t* Y, const float* outg, int b, int qb, LAS float* red, int wid, int lane) {
    const int h = wid, q = lane & 31, hi = lane >> 5;
    const int kperm = (q & 19) | ((q & 4) << 1) | ((q & 8) >> 1);
    const size_t rowA = (size_t)b * SEQ + 64 * qb + q;
    bf16x8 qfA[4], qfB[4];
#pragma unroll
    for (int kb = 0; kb < 4; ++kb) { qfA[kb] = *(const bf16x8*)(PROJ + rowA * INW + 1024 + h * 64 + 16 * kb + 8 * hi); qfB[kb] = *(const bf16x8*)(PROJ + (rowA + 32) * INW + 1024 + h * 64 + 16 * kb + 8 * hi); }
    f32x16 oA0, oA1, oB0, oB1;
#pragma unroll
    for (int r = 0; r < 16; ++r) { oA0[r] = 0.f; oA1[r] = 0.f; oB0[r] = 0.f; oB1[r] = 0.f; }
    float carryA = 1.f, carryB = 1.f;
    const bf16_t* Kbase = PROJ + ((size_t)b * SEQ + kperm) * INW + 1536 + h * 64 + 8 * hi;
    const bf16_t* Vbase = VT + (size_t)(h * 64 + q) * M + (size_t)b * SEQ + 8 * hi;
    bf16x8 kf[4], kn[4], vf[2][2];
#define LOADK(KF, kt_) do { _Pragma("unroll") for (int kb = 0; kb < 4; ++kb) KF[kb] = *(const bf16x8*)(Kbase + (size_t)(32 * (kt_)) * INW + 16 * kb); } while (0)
#define LOADV(VF, kt_) do { _Pragma("unroll") for (int d0 = 0; d0 < 2; ++d0) _Pragma("unroll") for (int k2 = 0; k2 < 2; ++k2) VF[d0][k2] = *(const bf16x8*)(Vbase + (size_t)(32 * d0) * M + 32 * (kt_) + 16 * k2); } while (0)
    const int ktop = 2 * qb + 1;
    LOADK(kf, ktop);
    for (int kt = ktop; kt >= 0; --kt) {
        LOADV(vf, kt);
        if (kt > 0) LOADK(kn, kt - 1);
        if (!__all(carryB == 0.f)) sb_tile(kf, qfB, vf, kt == ktop, q, hi, carryB, oB0, oB1);
        if (kt < ktop && !__all(carryA == 0.f)) sb_tile(kf, qfA, vf, kt == ktop - 1, q, hi, carryA, oA0, oA1);
        if (__all(carryA == 0.f && carryB == 0.f)) break;
#pragma unroll
        for (int kb = 0; kb < 4; ++kb) kf[kb] = kn[kb];
    }
#undef LOADK
#undef LOADV
    float ssA = 0.f, ssB = 0.f;
#pragma unroll
    for (int r = 0; r < 16; ++r) { ssA += oA0[r] * oA0[r] + oA1[r] * oA1[r]; ssB += oB0[r] * oB0[r] + oB1[r] * oB1[r]; }
    ssA += __shfl_xor(ssA, 32); ssB += __shfl_xor(ssB, 32);
    if (hi == 0) { red[wid * 64 + q] = ssA; red[wid * 64 + 32 + q] = ssB; }
    __syncthreads();
    float totA = 0.f, totB = 0.f;
#pragma unroll
    for (int w = 0; w < 8; ++w) { totA += red[w * 64 + q]; totB += red[w * 64 + 32 + q]; }
    bf16_t* yp = Y + rowA * DM + 512 + h * 64 + 4 * hi;
    LAS unsigned char* wt = (LAS unsigned char*)red + 2048 + wid * 8192;
    sb_stage(wt, q, hi, oA0, oA1, rsqrtf(totA * (1.f / 512.f) + RMS_EPS));
    sb_stage(wt, 32 + q, hi, oB0, oB1, rsqrtf(totB * (1.f / 512.f) + RMS_EPS));
    { const int rr = lane >> 3, cc = lane & 7;
      bf16_t* yrow = Y + ((size_t)b * SEQ + 64 * qb + rr) * DM + 512 + h * 64 + cc * 8;
#pragma unroll
      for (int j = 0; j < 8; ++j) { const int r = rr + 8 * j; const u32x4 v = *(const LAS u32x4*)(wt + r * 128 + ((cc ^ (r & 7)) * 16)); *(u32x4*)(yrow + (size_t)(8 * j) * DM) = v; } }
    __syncthreads();
}

__device__ __forceinline__ void conv_unit(const bf16_t* PROJ, bf16_t* Y, const float* cw, const float* cb, const float* lg, const float* lb, const float* outg,
                                          int b, int ti, LAS float* hbuf, LAS float* cbuf, int wid, int lane) {
    const int tid = wid * 64 + lane, t0 = 32 * ti;
    float w[31];
#pragma unroll
    for (int j = 0; j < 31; ++j) w[j] = cw[j * 256 + (tid & 255)];
    const float bias = cb[tid & 255];
    {
        u32x4 va[4], ga[4];
#pragma unroll
        for (int k = 0; k < 4; ++k) { const int it = tid + 512 * k, rr = it >> 5, c8 = (it & 31) * 8, t = t0 - 30 + rr;
            if (it < 62 * 32 && t >= 0) { const bf16_t* p = PROJ + ((size_t)b * SEQ + t) * INW + c8; va[k] = *(const u32x4*)p; ga[k] = *(const u32x4*)(p + 256); }
            else { va[k] = (u32x4){0u, 0u, 0u, 0u}; ga[k] = (u32x4){0u, 0u, 0u, 0u}; } }
#pragma unroll
        for (int k = 0; k < 4; ++k) { const int it = tid + 512 * k, rr = it >> 5, c8 = (it & 31) * 8;
            if (it < 62 * 32) {
                f32x4 h0, h1;
                h0[0] = bflo(va[k].x) * sigmoidf_(bflo(ga[k].x)); h0[1] = bfhi(va[k].x) * sigmoidf_(bfhi(ga[k].x));
                h0[2] = bflo(va[k].y) * sigmoidf_(bflo(ga[k].y)); h0[3] = bfhi(va[k].y) * sigmoidf_(bfhi(ga[k].y));
                h1[0] = bflo(va[k].z) * sigmoidf_(bflo(ga[k].z)); h1[1] = bfhi(va[k].z) * sigmoidf_(bfhi(ga[k].z));
                h1[2] = bflo(va[k].w) * sigmoidf_(bflo(ga[k].w)); h1[3] = bfhi(va[k].w) * sigmoidf_(bfhi(ga[k].w));
                *(LAS f32x4*)(hbuf + rr * 256 + c8) = h0; *(LAS f32x4*)(hbuf + rr * 256 + c8 + 4) = h1;
            } }
    }
    __syncthreads();
    {
        const int c = tid & 255, half = tid >> 8;
        float acc[16];
#pragma unroll
        for (int tt = 0; tt < 16; ++tt) acc[tt] = bias;
#pragma unroll
        for (int i = 0; i < 46; ++i) {
            const float v = hbuf[(half * 16 + i) * 256 + c];
#pragma unroll
            for (int tt = 0; tt < 16; ++tt) { const int j = i - tt; if (j >= 0 && j <= 30) acc[tt] += w[j] * v; }
        }
#pragma unroll
        for (int tt = 0; tt < 16; ++tt) cbuf[(half * 16 + tt) * 256 + c] = acc[tt];
    }
    __syncthreads();
    {
        const f32x4 gv = *(const f32x4*)(lg + 4 * lane), bv = *(const f32x4*)(lb + 4 * lane);
        f32x4 x[4]; float sv[8];
#pragma unroll
        for (int k = 0; k < 4; ++k) { x[k] = *(LAS f32x4*)(cbuf + (wid + 8 * k) * 256 + 4 * lane);
            sv[2 * k] = (x[k][0] + x[k][1]) + (x[k][2] + x[k][3]); sv[2 * k + 1] = dot4(x[k]); }
        wave_sum_n8(sv);
        f32x4 sl[4]; float rs[4];
#pragma unroll
        for (int k = 0; k < 4; ++k) {
            const float mean = sv[2 * k] * (1.f / 256.f);
            const float rstd = rsqrtf(fmaxf(sv[2 * k + 1] * (1.f / 256.f) - mean * mean, 0.f) + LN_EPS);
#pragma unroll
            for (int j = 0; j < 4; ++j) { const float y = (x[k][j] - mean) * rstd * gv[j] + bv[j]; sl[k][j] = y * sigmoidf_(y); }
            rs[k] = dot4(sl[k]);
        }
        wave_sum_n4(rs);
#pragma unroll
        for (int k = 0; k < 4; ++k) {
            const float rinv = rsqrtf(rs[k] * (1.f / 256.f) + RMS_EPS);
            u32x2 o; o.x = cvtpk(sl[k][0] * rinv, sl[k][1] * rinv); o.y = cvtpk(sl[k][2] * rinv, sl[k][3] * rinv);
            *(u32x2*)(Y + ((size_t)b * SEQ + t0 + wid + 8 * k) * DM + 4 * lane) = o;
        }
    }
    __syncthreads();
}

constexpr int VT_P = 136;
__device__ __forceinline__ void sg_unit(const bf16_t* PROJ, bf16_t* Y, const bf16_t* WSG, const float* sgb, const float* lg, const float* lb, const float* outg,
                                        int b, int n, int th, LAS bf16_t* vT, LAS float* red, int wid, int lane) {
    const int smax = 64 * (th + 1);
    const size_t row0 = (size_t)b * SEQ + 128 * n;
    {
        const f32x4 gv = *(const f32x4*)(lg + 4 * lane), bv = *(const f32x4*)(lb + 4 * lane);
        const int ntrip = smax >> 5;
        u32x2 raw[4][4];
#pragma unroll
        for (int i = 0; i < 4; ++i) if (i < ntrip) {
#pragma unroll
            for (int k = 0; k < 4; ++k) raw[i][k] = *(const u32x2*)(PROJ + (row0 + 32 * i + 4 * wid + k) * INW + 768 + 4 * lane); }
#pragma unroll
        for (int i = 0; i < 4; ++i) if (i < ntrip) {
            f32x4 x[4]; float sv[8];
#pragma unroll
            for (int k = 0; k < 4; ++k) { x[k] = (f32x4){gelu_erf(bflo(raw[i][k].x)), gelu_erf(bfhi(raw[i][k].x)), gelu_erf(bflo(raw[i][k].y)), gelu_erf(bfhi(raw[i][k].y))};
                sv[2 * k] = (x[k][0] + x[k][1]) + (x[k][2] + x[k][3]); sv[2 * k + 1] = dot4(x[k]); }
            wave_sum_n8(sv);
#pragma unroll
            for (int k = 0; k < 4; ++k) {
                const float mean = sv[2 * k] * (1.f / 256.f);
                const float rstd = rsqrtf(fmaxf(sv[2 * k + 1] * (1.f / 256.f) - mean * mean, 0.f) + LN_EPS);
#pragma unroll
                for (int j = 0; j < 4; ++j) x[k][j] = (x[k][j] - mean) * rstd * gv[j] + bv[j];
            }
#pragma unroll
            for (int j = 0; j < 4; ++j) { u32x2 w; w.x = cvtpk(x[0][j], x[1][j]); w.y = cvtpk(x[2][j], x[3][j]);
                *(LAS u32x2*)(vT + (4 * lane + j) * VT_P + 32 * i + 4 * wid) = w; }
        }
    }
    __syncthreads();
    const int nt2 = wid & 1, cq = wid >> 1, t31 = lane & 31, hi = lane >> 5;
    const int tl = 64 * th + 32 * nt2 + t31;
    f32x16 acc0, acc1;
#pragma unroll
    for (int r = 0; r < 16; ++r) { acc0[r] = 0.f; acc1[r] = 0.f; }
    const int nkb = 2 * (2 * th + nt2 + 1);
    const bf16_t* wrow = WSG + ((size_t)cq * 128 + tl) * 128 + 8 * hi;
    const LAS bf16_t* a0 = vT + (64 * cq + t31) * VT_P + 8 * hi;
    bf16x8 Bf[8];
#pragma unroll
    for (int kb = 0; kb < 8; ++kb) if (kb < nkb) Bf[kb] = *(const bf16x8*)(wrow + 16 * kb);
    const bf16_t* up = PROJ + (row0 + tl) * INW + 512 + 64 * cq + 4 * hi;
    u32x2 ur0[4], ur1[4];
#pragma unroll
    for (int a = 0; a < 4; ++a) { ur0[a] = *(const u32x2*)(up + 8 * a); ur1[a] = *(const u32x2*)(up + 32 + 8 * a); }
    const float bias = sgb[cq * 128 + tl];
#pragma unroll
    for (int kb = 0; kb < 8; ++kb) if (kb < nkb) {
        const bf16x8 A0 = *(const LAS bf16x8*)(a0 + 16 * kb), A1 = *(const LAS bf16x8*)(a0 + 32 * VT_P + 16 * kb);
        acc0 = __builtin_amdgcn_mfma_f32_32x32x16_bf16(A0, Bf[kb], acc0, 0, 0, 0);
        acc1 = __builtin_amdgcn_mfma_f32_32x32x16_bf16(A1, Bf[kb], acc1, 0, 0, 0);
    }
    float ss = 0.f;
#pragma unroll
    for (int a = 0; a < 4; ++a) {
        const u32x2 r0 = ur0[a], r1 = ur1[a];
        acc0[4 * a + 0] = gelu_erf(bflo(r0.x)) * (acc0[4 * a + 0] + bias); acc0[4 * a + 1] = gelu_erf(bfhi(r0.x)) * (acc0[4 * a + 1] + bias);
        acc0[4 * a + 2] = gelu_erf(bflo(r0.y)) * (acc0[4 * a + 2] + bias); acc0[4 * a + 3] = gelu_erf(bfhi(r0.y)) * (acc0[4 * a + 3] + bias);
        acc1[4 * a + 0] = gelu_erf(bflo(r1.x)) * (acc1[4 * a + 0] + bias); acc1[4 * a + 1] = gelu_erf(bfhi(r1.x)) * (acc1[4 * a + 1] + bias);
        acc1[4 * a + 2] = gelu_erf(bflo(r1.y)) * (acc1[4 * a + 2] + bias); acc1[4 * a + 3] = gelu_erf(bfhi(r1.y)) * (acc1[4 * a + 3] + bias);
    }
#pragma unroll
    for (int r = 0; r < 16; ++r) ss += acc0[r] * acc0[r] + acc1[r] * acc1[r];
    ss += __shfl_xor(ss, 32);
    if (hi == 0) red[cq * 64 + 32 * nt2 + t31] = ss;
    __syncthreads();
    const int tloc = 32 * nt2 + t31;
    const float rinv = rsqrtf(((red[tloc] + red[64 + tloc]) + (red[128 + tloc] + red[192 + tloc])) * (1.f / 256.f) + RMS_EPS);
    bf16_t* yp = Y + (row0 + tl) * DM + 256 + 64 * cq + 4 * hi;
#pragma unroll
    for (int a = 0; a < 4; ++a) {
        u32x2 o; o.x = cvtpk(acc0[4 * a] * rinv, acc0[4 * a + 1] * rinv); o.y = cvtpk(acc0[4 * a + 2] * rinv, acc0[4 * a + 3] * rinv);
        *(u32x2*)(yp + 8 * a) = o;
        u32x2 p; p.x = cvtpk(acc1[4 * a] * rinv, acc1[4 * a + 1] * rinv); p.y = cvtpk(acc1[4 * a + 2] * rinv, acc1[4 * a + 3] * rinv);
        *(u32x2*)(yp + 32 + 8 * a) = p;
    }
    __syncthreads();
}

#ifdef PROBE_BARX2
#define GSYNC() do { xcd_barrier(bar); xcd_barrier(bar); } while (0)
#else
#define GSYNC() xcd_barrier(bar)
#endif
struct Args { const float* in[18]; float* out; unsigned char* ws; };
__device__ __forceinline__ void convert_item(const Args& a, unsigned char* ws, int l, int r, LAS float* scr, int lane) {
    bf16_t* wl = (bf16_t*)(ws + WS_W + (size_t)l * W_LAYER);
    if (r < 1280) { const int kb = r / 80, nb = r - kb * 80, n0 = 32 * nb, pn = n0 >> 8, p = n0 & 255, bj = p >> 7, wc = (p >> 5) & 3;
        transpose_item(a.in[2] + (size_t)l * DM * INW, DM, INW, wl + WOFF_IN / 2, a.in[1] + l * DM, scr, kb, n0, 256 * inproj_ltile(pn) + 64 * wc + 32 * bj, lane); }
    else if (r < 1792) { r -= 1280; const int kb = r >> 5, nb = r & 31;
        transpose_item(a.in[14] + (size_t)l * DM * DM, DM, DM, wl + WOFF_OUT / 2, a.in[13] + l * DM, scr, kb, 32 * nb, 32 * nb, lane); }
    else if (r < 4608) { r -= 1792; const int kb = r / 176, nb = r - kb * 176, n0 = 32 * nb, pn = n0 >> 8, p = n0 & 255, bj = p >> 7, q = (p >> 5) & 3;
        transpose_item(a.in[16] + (size_t)l * DM * GUW, DM, GUW, wl + WOFF_GU / 2, a.in[15] + l * DM, scr, kb, n0, (bj ? FFH : 0) + 128 * pn + 32 * q, lane); }
    else { r -= 4608; const int kb = r >> 5, nb = r & 31;
        transpose_item(a.in[17] + (size_t)l * FFH * DM, FFH, DM, wl + WOFF_DN / 2, nullptr, scr, kb, 32 * nb, 32 * nb, lane); }
}
__global__ void __launch_bounds__(512, 2) mega_fwd(Args a) {
    extern __shared__ __attribute__((aligned(16))) unsigned char lds_raw[];
    LAS unsigned char* lds = (LAS unsigned char*)lds_raw;
    const int tid = threadIdx.x, lane = tid & 63, wid = __builtin_amdgcn_readfirstlane(tid >> 6);
    const int G = gridDim.x, bx = blockIdx.x, gw = bx * 8 + wid, NGW = G * 8;
    unsigned char* ws = a.ws;
    const float* x_in = a.in[0];
    float* SSA = (float*)(ws + WS_SS); float* SSB = (float*)(ws + WS_SSB);
    bf16_t* WSG = (bf16_t*)(ws + WS_WSG);
    bf16_t* XB = (bf16_t*)(ws + WS_XB); bf16_t* Yb = (bf16_t*)(ws + WS_Y); bf16_t* PROJ = (bf16_t*)(ws + WS_PROJ); bf16_t* VT = (bf16_t*)(ws + WS_VT); bf16_t* Hb = (bf16_t*)(ws + WS_H);
    float* out = a.out;
    volatile LAS unsigned* bst = (volatile LAS unsigned*)(lds + LDS_BYTES - 16);
    if (tid < 4) bst[tid] = 0u;
    __syncthreads();
    XcdBarrier bar = xcd_barrier_post((unsigned*)(ws + WS_BAR), bst);
    if (a.ws == nullptr) cg::this_grid().sync();

#ifdef PROBE_P0X2
    for (int rep_ = 0; rep_ < 2; ++rep_)
#endif
    {
        LAS float* scr = (LAS float*)(lds + wid * 8448);
        for (int it = gw; it < 6016; it += NGW) convert_item(a, ws, 0, it, scr, lane);
        for (int m = gw; m < M; m += NGW) {
            const f32x4* xr = (const f32x4*)(x_in + (size_t)m * DM) + lane; float s = 0.f;
            u32x2* o = (u32x2*)(XB + (size_t)m * DM) + lane;
#pragma unroll
            for (int j = 0; j < 4; ++j) { const f32x4 v = __builtin_nontemporal_load(xr + 64 * j); s += dot4(v); u32x2 w; w.x = cvtpk(v[0], v[1]); w.y = cvtpk(v[2], v[3]); o[64 * j] = w; }
            s = wave_sum(s); if (lane < 16) SSB[(size_t)m * 16 + lane] = lane == 0 ? s : 0.f;
        }
        for (int i = bx * 512 + tid; i < DEPTH * 4 * 128 * 128; i += G * 512) { const int s = i & 127, t = (i >> 7) & 127; WSG[i] = f2bf(s <= t ? a.in[9][i] : 0.f); }
    }
    GSYNC();

#define SPARE_CONVERT(lo, hi) do { if (l + 1 < DEPTH) { const bool half_ = (G == 256); if (!half_ || bx >= 128) { const int nw_ = (half_ ? 128 : G) * 8, w0_ = ((half_ ? bx - 128 : bx) * 8 + wid); \
        int lane_c = threadIdx.x & 63; asm volatile("" : "+v"(lane_c)); LAS float* scr_ = (LAS float*)(lds + wid * 8448); \
        for (int it = (lo) + w0_; it < (hi); it += nw_) convert_item(a, ws, l + 1, it, scr_, lane_c); } } } while (0)
    for (int l = 0; l < DEPTH; ++l) {
        const bf16_t* wl = (const bf16_t*)(ws + WS_W + (size_t)l * W_LAYER);
#ifdef PROBE_P1X2
        for (int rep_ = 0; rep_ < 2; ++rep_)
#endif
        { pg8::Gemm g{XB, wl + WOFF_IN / 2, M, INW, DM}; pg8::StaticOrder S; S.init(M, INW, G, bx);
          EpiInProj E{PROJ, VT, SSB, a.in[11] + l * 64, a.in[12] + l * 64};
          pg8::gemm_phase<EpiInProj, pg8::StaticOrder, true, true>(lds, g, S, E); }
        SPARE_CONVERT(0, 3008);
        GSYNC();
#ifdef PROBE_P2X2
        for (int rep_ = 0; rep_ < 2; ++rep_)
#endif
        {
            const float* outg = a.in[13] + l * DM;
            int lane_l = threadIdx.x & 63; asm volatile("" : "+v"(lane_l)); const int lane = lane_l;
#ifdef DIAG_FILL
            for (size_t i = (size_t)bx * 512 + threadIdx.x; i < (size_t)M * DM / 8; i += (size_t)G * 512) { const size_t r = i >> 7, c = (i & 127) * 8; *(u32x4*)(Yb + r * DM + c) = *(const u32x4*)(PROJ + r * INW + c); }
            GSYNC();
#endif
#ifndef DIAG_NOATTN
#ifdef PROBE_ATTNX2
            for (int rep2_ = 0; rep2_ < 2; ++rep2_)
#endif
            for (int p = bx; p < 256; p += G) {
                const int b = p & 7, s = p >> 3;
                attn_unit(PROJ, VT, Yb, outg + 512, b, s, (LAS float*)lds, wid, lane);
            }
#endif
#ifndef DIAG_NOCONV
#ifdef PROBE_CONVX2
            for (int rep2_ = 0; rep2_ < 2; ++rep2_)
#endif
            for (int id = bx; id < 512; id += G)
                conv_unit(PROJ, Yb, a.in[3] + l * 31 * 256, a.in[4] + l * 256, a.in[5] + l * 256, a.in[6] + l * 256, outg, id & 7, (id >> 3) & 63, (LAS float*)lds, (LAS float*)(lds + 63488), wid, lane);
#endif
#ifndef DIAG_NOSG
#ifdef PROBE_SGX2
            for (int rep2_ = 0; rep2_ < 2; ++rep2_)
#endif
            for (int id = bx; id < 256; id += G)
                sg_unit(PROJ, Yb, WSG + (size_t)l * 4 * 128 * 128, a.in[10] + l * 512, a.in[7] + l * 256, a.in[8] + l * 256, outg + 256, id & 7, (id >> 4) & 15, (id >> 3) & 1,
                        (LAS bf16_t*)lds, (LAS float*)(lds + 69632), wid, lane);
#endif
        }
        GSYNC();
        { pg8::Gemm g{Yb, wl + WOFF_OUT / 2, M, DM, DM}; pg8::StaticOrder S; S.init(M, DM, G, bx);
          EpiRes E{l == 0 ? x_in : nullptr, nullptr, XB, SSA};
          pg8::gemm_phase<EpiRes, pg8::StaticOrder, true, true>(lds, g, S, E); }
        GSYNC();
#ifdef PROBE_P4X2
        for (int rep_ = 0; rep_ < 2; ++rep_)
#endif
        { pg8::Gemm g{XB, wl + WOFF_GU / 2, M, GUW, DM}; pg8::StaticOrder S; S.init(M, GUW, G, bx);
          EpiSwiglu E{Hb, SSA};
          pg8::gemm_phase<EpiSwiglu, pg8::StaticOrder, true, true>(lds, g, S, E); }
        SPARE_CONVERT(3008, 6016);
        GSYNC();
        { pg8::Gemm g{Hb, wl + WOFF_DN / 2, M, DM, FFH}; pg8::StaticOrder S; S.init(M, DM, G, bx);
          const bool last = (l == DEPTH - 1);
          EpiRes E{nullptr, last ? out : nullptr, XB, SSB};
          pg8::gemm_phase<EpiRes, pg8::StaticOrder, true, true>(lds, g, S, E); }
        if (l + 1 < DEPTH) GSYNC();
    }
}

extern "C" void kernel_launch(void* const* d_in, const int* in_sizes, int n_in, void* d_out, int out_size, void* d_ws, size_t ws_size, hipStream_t stream) {
    static int grid = 0;
    if (grid == 0) {
        if (n_in != 18 || in_sizes[0] != M * DM || out_size != M * DM || ws_size < WS_END) { fprintf(stderr, "kernel_launch: unexpected shapes (n_in %d, in0 %d, out %d, ws %zu)\n", n_in, n_in > 0 ? in_sizes[0] : -1, out_size, ws_size); grid = -1; return; }
        int dev = 0, cus = 0, per_cu = 0;
        if (hipGetDevice(&dev) != hipSuccess || hipDeviceGetAttribute(&cus, hipDeviceAttributeMultiprocessorCount, dev) != hipSuccess) { grid = -1; return; }
        if (hipFuncSetAttribute((const void*)mega_fwd, hipFuncAttributeMaxDynamicSharedMemorySize, LDS_BYTES) != hipSuccess) { fprintf(stderr, "kernel_launch: hipFuncSetAttribute failed\n"); grid = -1; return; }
        if (hipOccupancyMaxActiveBlocksPerMultiprocessor(&per_cu, (const void*)mega_fwd, 512, LDS_BYTES) != hipSuccess || per_cu < 1) { fprintf(stderr, "kernel_launch: occupancy query gave %d\n", per_cu); per_cu = 1; }
        (void)hipGetLastError();
        grid = cus * per_cu;
        fprintf(stderr, "kernel_launch: grid %d (%d CUs x %d)\n", grid, cus, per_cu);
    }
    if (grid < 0) return;
    if (hipMemsetAsync((char*)d_ws + WS_BAR, 0, BAR_BYTES, stream) != hipSuccess) { fprintf(stderr, "kernel_launch: memset failed\n"); return; }
    Args a{};
    for (int i = 0; i < 18; ++i) a.in[i] = (const float*)d_in[i];
    a.out = (float*)d_out; a.ws = (unsigned char*)d_ws;
    void* args[] = {&a};
    hipError_t e = hipLaunchCooperativeKernel((const void*)mega_fwd, dim3(grid), dim3(512), args, LDS_BYTES, stream);
    if (e != hipSuccess) fprintf(stderr, "kernel_launch: cooperative launch failed: %s (grid %d)\n", hipGetErrorString(e), grid);
}
```

```cpp
#include <hip/hip_runtime.h>
#include <hip/hip_cooperative_groups.h>
#include <cstdio>
#include <cstdint>
namespace cg = cooperative_groups;
namespace pg8 {
#define PG8_LAS __attribute__((address_space(3)))
typedef unsigned short bf16_t;
typedef short bf16x8 __attribute__((ext_vector_type(8)));
typedef float f32x4 __attribute__((ext_vector_type(4)));
typedef unsigned u32x4 __attribute__((ext_vector_type(4)));
constexpr int BM = 256, BK = 64, HALF = 128, HTB = HALF * BK * 2  , STAGE_BYTES = 8 * HTB, NXCD = 8, WGM = 8;

__host__ __device__ __forceinline__ int lds_byte(int r, int c) { const int st = (r >> 4) * 2 + (c >> 5), rr = r & 15, cc = c & 31, ob = rr * 64 + cc * 2; return st * 1024 + (ob ^ (((ob >> 9) & 1) << 5)); }
__host__ __device__ __forceinline__ void stage_rc(int b, int& R, int& C) { const int st = b / 1024, sb = b % 1024, swz = sb ^ (((sb >> 9) & 1) << 5); R = (st >> 1) * 16 + swz / 64; C = (st & 1) * 32 + (swz % 64) / 2; }
__host__ __device__ __forceinline__ int perm32(int rho) { const int n = rho >> 4, i = rho & 15; return 8 * (i >> 2) + 4 * n + (i & 3); }

struct Unit { int pm, pn; };
struct Gemm { const bf16_t* A; const bf16_t* Bt; int M, N, K; };

struct StaticOrder {
    int nM, nN, nwg, G, c;
    __host__ __device__ void init(int M, int N, int G_, int c_) { nM = M / BM; nN = N / BM; nwg = nM * nN; G = G_; c = c_; }
    __host__ __device__ bool next(int i, Unit& u) const {
        const long L = (long)i * G + c; if (L >= nwg) return false;
        int wgid = (int)L; { const int q = nwg / NXCD, r = nwg % NXCD, xcd = wgid % NXCD, off = wgid / NXCD; wgid = (xcd < r ? xcd * (q + 1) : r * (q + 1) + (xcd - r) * q) + off; }
        const int nig = WGM * nN, gid = wgid / nig, fm = gid * WGM, gsz = (nM - fm) < WGM ? (nM - fm) : WGM;
        u.pm = fm + ((wgid % nig) % gsz); u.pn = (wgid % nig) / gsz; return true;
    }
    __device__ __forceinline__ void a_ready(const Unit&) const {}
    __device__ __forceinline__ void done(const Unit&) const {}
};

__device__ __forceinline__ unsigned cvt_pk_bf16(float lo, float hi) { unsigned r; asm volatile("v_cvt_pk_bf16_f32 %0, %1, %2" : "=v"(r) : "v"(lo), "v"(hi)); return r; }
typedef float f32x2 __attribute__((ext_vector_type(2)));
template <class Epi, class Sched, bool ALIGN_EPI = false, bool SP2 = false>
__device__ __forceinline__ void gemm_phase(PG8_LAS unsigned char* lds, const Gemm g, const Sched& S, const Epi& E) {
    int tid_l = threadIdx.x; asm volatile("" : "+v"(tid_l)); const int tid = tid_l, wid = __builtin_amdgcn_readfirstlane(tid >> 6), lane = tid & 63, wr = wid >> 2, wc = wid & 3, fr = lane & 15, fq = lane >> 4;
    const int K = g.K, nt = K / BK;
    unsigned voffA[2], voffB[2];
#pragma unroll
    for (int i = 0; i < 2; ++i) { int R, C; stage_rc(tid * 16 + i * 8192, R, C); const int Rb = Epi::PERM ? ((R & ~31) + perm32(R & 31)) : R;
        voffA[i] = (unsigned)(R * K + C) * 2u; voffB[i] = (unsigned)(Rb * K + C) * 2u; }
    const size_t kstep = (size_t)(BK * 2);
    const size_t hstep = (size_t)HALF * K * 2;
    const size_t tstep = 2 * hstep;
    const unsigned ldsw = (unsigned)wid * 1024u;
    const int aoff = lds_byte(wr * 64 + fr, fq * 8), boff = lds_byte(wc * 32 + fr, fq * 8);
#define PG8_SA(b, h) (((b) * 2 + (h)) * HTB)
#define PG8_SB(b, h) ((4 + (b) * 2 + (h)) * HTB)
#define PG8_STAGE(bufoff, gbase, voff) do { _Pragma("unroll") for (int _i = 0; _i < 2; ++_i) \
        __builtin_amdgcn_global_load_lds((const unsigned*)((const char*)(gbase) + (voff)[_i]), (PG8_LAS unsigned*)(lds + (bufoff) + ldsw + _i * 8192), 16, 0, 0); } while (0)
#define PG8_LDA(dst, b, h) do { _Pragma("unroll") for (int m = 0; m < 4; ++m) _Pragma("unroll") for (int k = 0; k < 2; ++k) dst[m][k] = *(const PG8_LAS bf16x8*)(lds + PG8_SA(b, h) + aoff + m * 2048 + k * 1024); } while (0)
#define PG8_LDB(dst, b, h) do { _Pragma("unroll") for (int n = 0; n < 2; ++n) _Pragma("unroll") for (int k = 0; k < 2; ++k) dst[n][k] = *(const PG8_LAS bf16x8*)(lds + PG8_SB(b, h) + boff + n * 2048 + k * 1024); } while (0)
#define PG8_MMA(ai, bj, At, Bt) do { __builtin_amdgcn_s_setprio(1); _Pragma("unroll") for (int m = 0; m < 4; ++m) _Pragma("unroll") for (int n = 0; n < 2; ++n) _Pragma("unroll") for (int k = 0; k < 2; ++k) \
        acc[ai][bj][m][n] = __builtin_amdgcn_mfma_f32_16x16x32_bf16(Bt[n][k], At[m][k], acc[ai][bj][m][n], 0, 0, 0); __builtin_amdgcn_s_setprio(0); } while (0)
#define PG8_WAIT_V(n) asm volatile("s_waitcnt vmcnt(" #n ")" ::: "memory")
#define PG8_WAIT_L(n) asm volatile("s_waitcnt lgkmcnt(" #n ")" ::: "memory")
#define PG8_BAR __builtin_amdgcn_s_barrier()
#define PG8_SCHED __builtin_amdgcn_sched_barrier(0)
    Unit cur, nxt; int ui = 0;
    if (!S.next(0, cur)) return;
    f32x4 acc[2][2][4][2];
#pragma unroll
    for (int a = 0; a < 2; ++a)
#pragma unroll
        for (int b = 0; b < 2; ++b)
#pragma unroll
            for (int m = 0; m < 4; ++m)
#pragma unroll
                for (int n = 0; n < 2; ++n) acc[a][b][m][n] = (f32x4){0.f, 0.f, 0.f, 0.f};
    bf16x8 At[4][2], B0[2][2], B1[2][2];
    const char* cA = (const char*)g.A + (size_t)cur.pm * tstep; const char* cB = (const char*)g.Bt + (size_t)cur.pn * tstep;
    S.a_ready(cur);
    if constexpr (SP2) {
        PG8_STAGE(PG8_SB(0, 0), cB, voffB); PG8_STAGE(PG8_SB(0, 1), cB + hstep, voffB); PG8_STAGE(PG8_SA(0, 0), cA, voffA); PG8_STAGE(PG8_SA(0, 1), cA + hstep, voffA);
        if (wr == 1) PG8_BAR;
        PG8_WAIT_V(2); PG8_BAR;
        PG8_STAGE(PG8_SB(1, 0), cB + kstep, voffB); PG8_STAGE(PG8_SA(1, 0), cA + kstep, voffA); PG8_STAGE(PG8_SB(1, 1), cB + hstep + kstep, voffB);
        PG8_WAIT_V(6); PG8_BAR;
    } else {
        PG8_STAGE(PG8_SB(0, 0), cB, voffB); PG8_STAGE(PG8_SA(0, 0), cA, voffA); PG8_STAGE(PG8_SB(0, 1), cB + hstep, voffB); PG8_STAGE(PG8_SA(0, 1), cA + hstep, voffA);
        if (wr == 1) PG8_BAR;
        PG8_WAIT_V(4); PG8_BAR;
        PG8_STAGE(PG8_SB(1, 0), cB + kstep, voffB); PG8_STAGE(PG8_SA(1, 0), cA + kstep, voffA); PG8_STAGE(PG8_SB(1, 1), cB + hstep + kstep, voffB);
        PG8_WAIT_V(6); PG8_BAR;
    }
    for (;;) {
        const bool has_next = S.next(ui + 1, nxt);
        const char* nA = has_next ? (const char*)g.A + (size_t)nxt.pm * tstep : cA; const char* nB = has_next ? (const char*)g.Bt + (size_t)nxt.pn * tstep : cB;
        asm volatile(".p2align 6");
        for (int t = 0; t < nt; t += 2) {
            const bool last = (t == nt - 2);
            const char* a1 = cA + (size_t)(t + 1) * kstep;
            const char* a2 = last ? nA : cA + (size_t)(t + 2) * kstep; const char* b2 = last ? nB : cB + (size_t)(t + 2) * kstep;
            const char* a3 = a2 + kstep; const char* b3 = b2 + kstep;
            if (last && has_next) S.a_ready(nxt);
            if constexpr (SP2) {
            PG8_LDB(B0, 0, 0); PG8_LDB(B1, 0, 1); PG8_SCHED; PG8_LDA(At, 0, 0); PG8_STAGE(PG8_SA(1, 1), a1 + hstep, voffA);
            PG8_WAIT_V(8); PG8_WAIT_L(0); PG8_BAR; PG8_MMA(0, 0, At, B0); PG8_MMA(0, 1, At, B1); PG8_BAR; PG8_SCHED;
            PG8_LDA(At, 0, 1); PG8_STAGE(PG8_SB(0, 0), b2, voffB); PG8_STAGE(PG8_SB(0, 1), b2 + hstep, voffB); PG8_STAGE(PG8_SA(0, 0), a2, voffA);
            PG8_WAIT_V(8); PG8_WAIT_L(0); PG8_BAR; PG8_MMA(1, 0, At, B0); PG8_MMA(1, 1, At, B1); PG8_BAR; PG8_SCHED;
            PG8_LDB(B0, 1, 0); PG8_LDB(B1, 1, 1); PG8_SCHED; PG8_LDA(At, 1, 0); PG8_STAGE(PG8_SA(0, 1), a2 + hstep, voffA);
            PG8_WAIT_V(8); PG8_WAIT_L(0); PG8_BAR; PG8_MMA(0, 0, At, B0); PG8_MMA(0, 1, At, B1); PG8_BAR; PG8_SCHED;
            PG8_LDA(At, 1, 1); PG8_STAGE(PG8_SB(1, 0), b3, voffB); PG8_STAGE(PG8_SB(1, 1), b3 + hstep, voffB); PG8_STAGE(PG8_SA(1, 0), a3, voffA);
            PG8_WAIT_V(8); PG8_WAIT_L(0); PG8_BAR; PG8_MMA(1, 0, At, B0); PG8_MMA(1, 1, At, B1); PG8_BAR; PG8_SCHED;
            } else {
            PG8_LDB(B0, 0, 0); PG8_SCHED; PG8_LDA(At, 0, 0); PG8_STAGE(PG8_SA(1, 1), a1 + hstep, voffA);
            PG8_WAIT_L(8); PG8_BAR; PG8_WAIT_L(0); PG8_MMA(0, 0, At, B0); PG8_BAR; PG8_SCHED;
            PG8_LDB(B1, 0, 1); PG8_STAGE(PG8_SB(0, 0), b2, voffB);
            PG8_BAR; PG8_WAIT_L(0); PG8_MMA(0, 1, At, B1); PG8_BAR;
            PG8_LDA(At, 0, 1); PG8_STAGE(PG8_SA(0, 0), a2, voffA);
            PG8_BAR; PG8_WAIT_L(0); PG8_MMA(1, 0, At, B0); PG8_BAR; PG8_SCHED;
            PG8_STAGE(PG8_SB(0, 1), b2 + hstep, voffB);
            PG8_WAIT_V(6); PG8_BAR; PG8_MMA(1, 1, At, B1); PG8_BAR;
            PG8_LDB(B0, 1, 0); PG8_SCHED; PG8_LDA(At, 1, 0); PG8_STAGE(PG8_SA(0, 1), a2 + hstep, voffA);
            PG8_WAIT_L(8); PG8_BAR; PG8_WAIT_L(0); PG8_MMA(0, 0, At, B0); PG8_BAR; PG8_SCHED;
            PG8_LDB(B1, 1, 1); PG8_STAGE(PG8_SB(1, 0), b3, voffB);
            PG8_BAR; PG8_WAIT_L(0); PG8_MMA(0, 1, At, B1); PG8_BAR;
            PG8_LDA(At, 1, 1); PG8_STAGE(PG8_SA(1, 0), a3, voffA);
            PG8_BAR; PG8_WAIT_L(0); PG8_MMA(1, 0, At, B0); PG8_BAR; PG8_SCHED;
            PG8_STAGE(PG8_SB(1, 1), b3 + hstep, voffB);
            PG8_WAIT_V(6); PG8_BAR; PG8_MMA(1, 1, At, B1); PG8_BAR;
            }
        }
        if constexpr (ALIGN_EPI) { if (wr == 0) PG8_BAR; }
        if constexpr (!Epi::AFTER_DRAIN) { E(acc, cur, wr, wc, fr, fq); S.done(cur); }
        if (!has_next) break;
#pragma unroll
        for (int a = 0; a < 2; ++a)
#pragma unroll
            for (int b = 0; b < 2; ++b)
#pragma unroll
                for (int m = 0; m < 4; ++m)
#pragma unroll
                    for (int n = 0; n < 2; ++n) acc[a][b][m][n] = (f32x4){0.f, 0.f, 0.f, 0.f};
        cur = nxt; cA = nA; cB = nB; ++ui;
        if constexpr (ALIGN_EPI) { if (wr == 1) PG8_BAR; }
    }
    PG8_WAIT_V(0);
    if constexpr (!ALIGN_EPI) { if (wr == 0) PG8_BAR; }
    PG8_BAR;
    if constexpr (Epi::AFTER_DRAIN) { E.fused(acc, cur, wr, wc, fr, fq, lds, wid, lane); S.done(cur); }
#undef PG8_SA
#undef PG8_SB
#undef PG8_STAGE
#undef PG8_LDA
#undef PG8_LDB
#undef PG8_MMA
#undef PG8_WAIT_V
#undef PG8_WAIT_L
#undef PG8_BAR
#undef PG8_SCHED
}
}
#define GAS __attribute__((address_space(1)))
#define LAS __attribute__((address_space(3)))
#define RLX_AGENT __ATOMIC_RELAXED, __HIP_MEMORY_SCOPE_AGENT
#define LDS_WAIT() asm volatile("s_waitcnt lgkmcnt(0)" ::: "memory")
#define VM_WAIT() asm volatile("s_waitcnt vmcnt(0)" ::: "memory")
__device__ __forceinline__ unsigned long long rt() { return __builtin_amdgcn_s_memrealtime(); }
#define XB_TMO      128
#define XB_XCNT(j)  (256  + 64 * (j))
#define XB_XSUB(j)  (1280 + 64 * (j))
#define XB_XGEN(j)  (2304 + 64 * (j))
#define XB_TOP      3328
#define XB_TOPGEN   3392
#define XCD_BAR_WORDS 3456
#define XB_SPIN_CAP (1u << 18)

__device__ __forceinline__ unsigned xb_ld(unsigned* p)              { return __hip_atomic_load(p, __ATOMIC_RELAXED, __HIP_MEMORY_SCOPE_AGENT); }
__device__ __forceinline__ unsigned xb_add(unsigned* p, unsigned v) { return __hip_atomic_fetch_add(p, v, __ATOMIC_RELAXED, __HIP_MEMORY_SCOPE_AGENT); }
__device__ __forceinline__ unsigned xb_xcc_id() { return (unsigned)__builtin_amdgcn_s_getreg((3 << 11) | 20) & 0xFu; }
#define XB_SPIN(cond, bar) do { unsigned _sp = 0; while (cond) { __builtin_amdgcn_s_sleep(1); \
    if ((++_sp & 255u) == 0u) { if (xb_ld(&(bar)[XB_TMO])) break; if (_sp > XB_SPIN_CAP) { atomicAdd(&(bar)[XB_TMO], 1u); break; } } } } while (0)

struct XcdBarrier {
    unsigned* bar; unsigned x;
    volatile LAS unsigned* st;
};

__device__ __forceinline__ XcdBarrier xcd_barrier_post(unsigned* bar, volatile LAS unsigned* st) {
    XcdBarrier b; b.bar = bar; b.x = xb_xcc_id(); b.st = st;
    if (threadIdx.x == 0) (void)xb_add(&bar[XB_XCNT(b.x)], 1u);
    return b;
}
__device__ __forceinline__ void xcd_barrier_complete(unsigned* bar, unsigned x, unsigned& nloc, unsigned& nx) {
    const unsigned G = gridDim.x * gridDim.y * gridDim.z;
    unsigned sum, cnt, mine, sp = 0u;
    for (;;) {
        sum = 0u; cnt = 0u; mine = 0u;
#pragma unroll
        for (unsigned j = 0; j < 16; ++j) { const unsigned c = xb_ld(&bar[XB_XCNT(j)]); sum += c; cnt += (c > 0u) ? 1u : 0u; mine = (j == x) ? c : mine; }
        if (sum == G) break;
        __builtin_amdgcn_s_sleep(1);
        if ((++sp & 255u) == 0u) { if (xb_ld(&bar[XB_TMO])) break; if (sp > XB_SPIN_CAP) { atomicAdd(&bar[XB_TMO], 1u); break; } }
    }
    nloc = mine > 0u ? mine : 1u; nx = cnt > 0u ? cnt : 1u;
}

__device__ __forceinline__ void xcd_barrier(const XcdBarrier& b) {
    asm volatile("s_waitcnt vmcnt(0)" ::: "memory");
    __syncthreads();
    if (threadIdx.x == 0) {
        unsigned* bar = b.bar;
        unsigned bx_ = b.x; asm volatile("" : "+s"(bx_));
        __builtin_amdgcn_s_waitcnt(0);
        unsigned nloc = b.st[0], nx = b.st[1];
        if (nloc == 0u) { xcd_barrier_complete(bar, bx_, nloc, nx); b.st[0] = nloc; b.st[1] = nx; }
        const unsigned old = xb_add(&bar[XB_XSUB(bx_)], 1u);
        const unsigned gen = old / nloc;
        if (old + 1u == (gen + 1u) * nloc) {
            __builtin_amdgcn_fence(__ATOMIC_RELEASE, "agent");
            asm volatile("s_waitcnt vmcnt(0)" ::: "memory");
            asm volatile("buffer_inv sc1" ::: "memory");
            const unsigned og = xb_add(&bar[XB_TOP], 1u);
            const unsigned tg = og / nx;
            if (og + 1u == (tg + 1u) * nx) xb_add(&bar[XB_TOPGEN], 1u);
            else XB_SPIN(xb_ld(&bar[XB_TOPGEN]) == tg, bar);
            xb_add(&bar[XB_XGEN(bx_)], 1u);
            asm volatile("s_waitcnt vmcnt(0)" ::: "memory");
        } else {
            asm volatile("buffer_inv sc1" ::: "memory");
            XB_SPIN(xb_ld(&bar[XB_XGEN(bx_)]) == gen, bar);
            asm volatile("s_waitcnt vmcnt(0)" ::: "memory");
        }
    }
    __syncthreads();
}
typedef unsigned short bf16_t;
typedef short bf16x8 __attribute__((ext_vector_type(8)));
typedef float f32x4 __attribute__((ext_vector_type(4)));
typedef float f32x16 __attribute__((ext_vector_type(16)));
typedef unsigned u32x4 __attribute__((ext_vector_type(4)));
typedef unsigned u32x2 __attribute__((ext_vector_type(2)));

constexpr int DM = 1024, NB = 8, SEQ = 2048, DEPTH = 4, M = NB * SEQ, INW = 2560, FFH = 2816, GUW = 5632;
constexpr float RMS_EPS = 1e-6f, LN_EPS = 1e-5f;
constexpr size_t MiB = 1u << 20;
constexpr size_t WS_SS = 0;
constexpr size_t WS_SSB = 256 * MiB;
constexpr size_t WS_BAR = 1536 * 1024, BAR_BYTES = 16384;
constexpr size_t WS_WSG = 1 * MiB;
constexpr size_t WS_W = 2 * MiB;
constexpr size_t W_LAYER = 47 * MiB / 2;
constexpr size_t WOFF_IN = 0, WOFF_OUT = 5 * MiB, WOFF_GU = 7 * MiB, WOFF_DN = 18 * MiB;
constexpr size_t WS_XB = 96 * MiB, WS_Y = 128 * MiB, WS_PROJ = 160 * MiB, WS_VT = 240 * MiB, WS_H = 160 * MiB, WS_END = 257 * MiB;
constexpr int LDS_BYTES = 135168;

__device__ __forceinline__ unsigned cvtpk(float lo, float hi) { typedef float f2 __attribute__((ext_vector_type(2))); typedef __bf16 b2 __attribute__((ext_vector_type(2))); f2 v = {lo, hi}; b2 b = __builtin_convertvector(v, b2); return __builtin_bit_cast(unsigned, b); }
__device__ __forceinline__ bf16_t f2bf(float f) { return (bf16_t)(cvtpk(f, 0.f) & 0xffffu); }
__device__ __forceinline__ float bf2f(unsigned short b) { return __uint_as_float((unsigned)b << 16); }
__device__ __forceinline__ float bflo(unsigned w) { return __uint_as_float(w << 16); }
__device__ __forceinline__ float bfhi(unsigned w) { return __uint_as_float(w & 0xffff0000u); }
__device__ __forceinline__ u32x4 pack8(f32x4 a, f32x4 b) { u32x4 w; w.x = cvtpk(a[0], a[1]); w.y = cvtpk(a[2], a[3]); w.z = cvtpk(b[0], b[1]); w.w = cvtpk(b[2], b[3]); return w; }
__device__ __forceinline__ float dot4(f32x4 a) { return (a[0] * a[0] + a[1] * a[1]) + (a[2] * a[2] + a[3] * a[3]); }
__device__ __forceinline__ float sigmoidf_(float x) { return __builtin_amdgcn_rcpf(1.f + __builtin_amdgcn_exp2f(x * -1.44269504089f)); }
__device__ __forceinline__ float gelu_erf(float v) {
    const float av = fabsf(v), t = __builtin_amdgcn_rcpf(av * 0.2316418882f + 1.0f);
    float q = t * 0.5307027145f + (-0.7265760135f); q = q * t + 0.7107068705f; q = q * t + (-0.142248368f); q = q * t + 0.127414796f; q = q * t;
    const float e = __builtin_amdgcn_exp2f((v * v) * (-0.72134752044f));
    const float m = v * (q * e);
    return v < 0.f ? m : v - m;
}
__device__ __forceinline__ void wave_sum_n8(float (&v)[8]) {
#pragma unroll
    for (int o = 1; o < 64; o <<= 1) { float t[8];
#pragma unroll
        for (int i = 0; i < 8; ++i) t[i] = __shfl_xor(v[i], o);
#pragma unroll
        for (int i = 0; i < 8; ++i) v[i] += t[i]; }
}
__device__ __forceinline__ void wave_sum_n4(float (&v)[4]) {
#pragma unroll
    for (int o = 1; o < 64; o <<= 1) { float t[4];
#pragma unroll
        for (int i = 0; i < 4; ++i) t[i] = __shfl_xor(v[i], o);
#pragma unroll
        for (int i = 0; i < 4; ++i) v[i] += t[i]; }
}
__device__ __forceinline__ void wave_sum2(float& a, float& b) {
#pragma unroll
    for (int o = 1; o < 64; o <<= 1) { const float ta = __shfl_xor(a, o), tb = __shfl_xor(b, o); a += ta; b += tb; }
}
__device__ __forceinline__ float wave_sum(float v) {
#pragma unroll
    for (int o = 1; o < 64; o <<= 1) v += __shfl_xor(v, o);
    return v;
}
__device__ __forceinline__ float row_rinv(const float* SS, int row) { const f32x4* p = (const f32x4*)(SS + (size_t)row * 16); const f32x4 a = p[0], b = p[1], c = p[2], d = p[3];
    const float s = ((a[0] + a[1]) + (a[2] + a[3])) + ((b[0] + b[1]) + (b[2] + b[3])) + ((c[0] + c[1]) + (c[2] + c[3])) + ((d[0] + d[1]) + (d[2] + d[3])); return rsqrtf(s * (1.f / 1024.f) + RMS_EPS); }
__device__ __forceinline__ int crow(int r, int hi) { return (r & 3) + 8 * (r >> 2) + 4 * hi; }

__host__ __device__ __forceinline__ int inproj_ltile(int pn) { return (pn == 2 || pn == 3) ? pn + 6 : ((pn == 8 || pn == 9) ? pn - 6 : pn); }
struct EpiInProj {
    static constexpr bool PERM = true, AFTER_DRAIN = false;
    bf16_t* PROJ; bf16_t* VT; const float* SS; const float* qg; const float* kg;
    __device__ __forceinline__ void operator()(const pg8::f32x4 (&acc)[2][2][4][2], const pg8::Unit& u, int wr, int wc, int fr, int fq) const {
        const int pn = inproj_ltile(u.pn);
        const int colbase = pn * 256 + 64 * wc + 8 * fq;
        f32x4 gqk[2][2];
        { const float* g = pn < 6 ? qg : kg;
#pragma unroll
          for (int bj = 0; bj < 2; ++bj)
#pragma unroll
            for (int n = 0; n < 2; ++n) gqk[bj][n] = (pn >= 4 && pn < 8) ? *(const f32x4*)(g + 32 * bj + 8 * fq + 4 * n) : (f32x4){1.f, 1.f, 1.f, 1.f}; }
        float rinvs[2][4];
        { f32x4 pv[2][4];
#pragma unroll
          for (int ai = 0; ai < 2; ++ai)
#pragma unroll
            for (int m = 0; m < 4; ++m) pv[ai][m] = *(const f32x4*)(SS + (size_t)(u.pm * 256 + ai * 128 + wr * 64 + m * 16 + fr) * 16 + 4 * fq);
#pragma unroll
          for (int ai = 0; ai < 2; ++ai)
#pragma unroll
            for (int m = 0; m < 4; ++m) { float s = (pv[ai][m][0] + pv[ai][m][1]) + (pv[ai][m][2] + pv[ai][m][3]); s += __shfl_xor(s, 16); s += __shfl_xor(s, 32); rinvs[ai][m] = rsqrtf(s * (1.f / 1024.f) + RMS_EPS); } }
#pragma unroll
        for (int ai = 0; ai < 2; ++ai)
#pragma unroll
            for (int m = 0; m < 4; ++m) {
                const int row = u.pm * 256 + ai * 128 + wr * 64 + m * 16 + fr;
                const float rinv = rinvs[ai][m];
                f32x4 v[2][2];
#pragma unroll
                for (int bj = 0; bj < 2; ++bj)
#pragma unroll
                    for (int n = 0; n < 2; ++n) v[bj][n] = acc[ai][bj][m][n] * rinv;
                if (pn >= 4 && pn < 8) {
                    float ss = (dot4(v[0][0]) + dot4(v[0][1])) + (dot4(v[1][0]) + dot4(v[1][1]));
                    ss += __shfl_xor(ss, 16); ss += __shfl_xor(ss, 32);
                    const float hr = rsqrtf(ss * (1.f / 64.f) + RMS_EPS) * (pn < 6 ? 0.125f * 1.44269504089f : 1.f);
#pragma unroll
                    for (int bj = 0; bj < 2; ++bj)
#pragma unroll
                        for (int n = 0; n < 2; ++n) v[bj][n] = v[bj][n] * gqk[bj][n] * hr;
                }
                if (pn < 8) {
#pragma unroll
                    for (int bj = 0; bj < 2; ++bj) *(u32x4*)(PROJ + (size_t)row * INW + colbase + 32 * bj) = pack8(v[bj][0], v[bj][1]);
                } else {
                    const int hd0 = ((pn - 8) * 4 + wc) * 64 + 8 * fq;
#pragma unroll
                    for (int bj = 0; bj < 2; ++bj)
#pragma unroll
                        for (int n = 0; n < 2; ++n)
#pragma unroll
                            for (int j = 0; j < 4; ++j) VT[(size_t)(hd0 + 32 * bj + 4 * n + j) * M + row] = f2bf(v[bj][n][j]);
                }
            }
    }
};
struct EpiRes {
    static constexpr bool PERM = true, AFTER_DRAIN = false;
    const float* base32; float* out32; bf16_t* XB; float* SSn;
    __device__ __forceinline__ void operator()(const pg8::f32x4 (&acc)[2][2][4][2], const pg8::Unit& u, int wr, int wc, int fr, int fq) const {
        const int col0 = u.pn * 256 + 32 * wc + 8 * fq;
#pragma unroll
        for (int ai = 0; ai < 2; ++ai)
#pragma unroll
            for (int mh = 0; mh < 2; ++mh) {
                const size_t off0 = (size_t)(u.pm * 256 + ai * 128 + wr * 64 + mh * 32 + fr) * DM + col0;
                f32x4 b0[2][2], b1[2][2];
                if (base32) {
#pragma unroll
                    for (int mm = 0; mm < 2; ++mm)
#pragma unroll
                        for (int bj = 0; bj < 2; ++bj) { const float* p = base32 + off0 + (size_t)mm * 16 * DM + 128 * bj;
                            b0[mm][bj] = __builtin_nontemporal_load((const f32x4*)p); b1[mm][bj] = __builtin_nontemporal_load((const f32x4*)(p + 4)); }
                } else {
                    u32x4 w[2][2];
#pragma unroll
                    for (int mm = 0; mm < 2; ++mm)
#pragma unroll
                        for (int bj = 0; bj < 2; ++bj) w[mm][bj] = *(const u32x4*)(XB + off0 + (size_t)mm * 16 * DM + 128 * bj);
#pragma unroll
                    for (int mm = 0; mm < 2; ++mm)
#pragma unroll
                        for (int bj = 0; bj < 2; ++bj) { const u32x4 x = w[mm][bj]; b0[mm][bj] = (f32x4){bflo(x.x), bfhi(x.x), bflo(x.y), bfhi(x.y)}; b1[mm][bj] = (f32x4){bflo(x.z), bfhi(x.z), bflo(x.w), bfhi(x.w)}; }
                }
#pragma unroll
                for (int mm = 0; mm < 2; ++mm) {
                    const int m = 2 * mh + mm;
                    const int row = u.pm * 256 + ai * 128 + wr * 64 + m * 16 + fr;
                    float ss = 0.f;
#pragma unroll
                    for (int bj = 0; bj < 2; ++bj) {
                        const size_t off = off0 + (size_t)mm * 16 * DM + 128 * bj;
                        const f32x4 v0 = b0[mm][bj] + acc[ai][bj][m][0], v1 = b1[mm][bj] + acc[ai][bj][m][1];
                        if (out32) { __builtin_nontemporal_store(v0, (f32x4*)(out32 + off)); __builtin_nontemporal_store(v1, (f32x4*)(out32 + off + 4)); }
                        else { *(u32x4*)(XB + off) = pack8(v0, v1); ss += dot4(v0) + dot4(v1); }
                    }
                    if (!out32) { ss += __shfl_xor(ss, 16); ss += __shfl_xor(ss, 32); if (fq == 0) SSn[(size_t)row * 16 + u.pn * 4 + wc] = ss; }
                }
            }
    }
};
struct EpiSwiglu {
    static constexpr bool PERM = true, AFTER_DRAIN = false;
    bf16_t* H; const float* SS;
    __device__ __forceinline__ void operator()(const pg8::f32x4 (&acc)[2][2][4][2], const pg8::Unit& u, int wr, int wc, int fr, int fq) const {
        const int col0 = u.pn * 128 + 32 * wc + 8 * fq;
        const __amdgpu_buffer_rsrc_t hrs = __builtin_amdgcn_make_buffer_rsrc(H, 0, M * FFH * 2, 0x00020000);
        float rinvs[2][4];
        { f32x4 pv[2][4];
#pragma unroll
          for (int ai = 0; ai < 2; ++ai)
#pragma unroll
            for (int m = 0; m < 4; ++m) pv[ai][m] = *(const f32x4*)(SS + (size_t)(u.pm * 256 + ai * 128 + wr * 64 + m * 16 + fr) * 16 + 4 * fq);
#pragma unroll
          for (int ai = 0; ai < 2; ++ai)
#pragma unroll
            for (int m = 0; m < 4; ++m) { float s = (pv[ai][m][0] + pv[ai][m][1]) + (pv[ai][m][2] + pv[ai][m][3]); s += __shfl_xor(s, 16); s += __shfl_xor(s, 32); rinvs[ai][m] = rsqrtf(s * (1.f / 1024.f) + RMS_EPS); } }
#pragma unroll
        for (int ai = 0; ai < 2; ++ai)
#pragma unroll
            for (int m = 0; m < 4; ++m) {
                const int row = u.pm * 256 + ai * 128 + wr * 64 + m * 16 + fr;
                const float rinv = rinvs[ai][m];
                f32x4 h[2];
#pragma unroll
                for (int n = 0; n < 2; ++n) {
                    const f32x4 g = acc[ai][0][m][n] * rinv, up = acc[ai][1][m][n] * rinv;
#pragma unroll
                    for (int j = 0; j < 4; ++j) h[n][j] = g[j] * sigmoidf_(g[j]) * up[j];
                }
                __builtin_amdgcn_raw_buffer_store_b128(pack8(h[0], h[1]), hrs, (unsigned)(((size_t)row * FFH + col0) * 2), 0,   16);
            }
    }
};

__device__ __forceinline__ void transpose_item(const float* W, int K, int N, bf16_t* WT, const float* gain, LAS float* scr, int kb, int n0, int src0, int lane) {
    const int k0 = 64 * kb;
    const float* src = W + (size_t)(k0 + (lane >> 5)) * N + src0 + (lane & 31);
    float w[32];
#pragma unroll
    for (int i = 0; i < 32; ++i) w[i] = __builtin_nontemporal_load(src + (size_t)(2 * i) * N);
    const int c = lane & 7;
    f32x4 g0 = {1.f, 1.f, 1.f, 1.f}, g1 = {1.f, 1.f, 1.f, 1.f};
    if (gain) { g0 = *(const f32x4*)(gain + k0 + 8 * c); g1 = *(const f32x4*)(gain + k0 + 8 * c + 4); }
#pragma unroll
    for (int i = 0; i < 32; ++i) scr[(2 * i + (lane >> 5)) * 33 + (lane & 31)] = w[i];
    asm volatile("s_waitcnt lgkmcnt(0)" ::: "memory");
#pragma unroll
    for (int j = 0; j < 4; ++j) { const int n = (lane >> 3) + 8 * j; const LAS float* s = scr + (8 * c) * 33 + n;
        u32x4 o; o.x = cvtpk(s[0 * 33] * g0[0], s[1 * 33] * g0[1]); o.y = cvtpk(s[2 * 33] * g0[2], s[3 * 33] * g0[3]); o.z = cvtpk(s[4 * 33] * g1[0], s[5 * 33] * g1[1]); o.w = cvtpk(s[6 * 33] * g1[2], s[7 * 33] * g1[3]);
        *(u32x4*)(WT + (size_t)(n0 + n) * K + k0 + 8 * c) = o; }
    asm volatile("s_waitcnt lgkmcnt(0)" ::: "memory");
}

__device__ __forceinline__ void sb_tile(const bf16x8 (&kf)[4], const bf16x8 (&qf)[4], const bf16x8 (&vf)[2][2], bool diag, int q, int hi, float& carry, f32x16& o0, f32x16& o1) {
    f32x16 z;
#pragma unroll
    for (int r = 0; r < 16; ++r) z[r] = 0.f;
#pragma unroll
    for (int kb = 0; kb < 4; ++kb) z = __builtin_amdgcn_mfma_f32_32x32x16_bf16(kf[kb], qf[kb], z, 0, 0, 0);
    float be[16], nb[16];
#pragma unroll
    for (int r = 0; r < 16; ++r) {
        const float zr = z[r];
        const float e = __builtin_amdgcn_exp2f(-fabsf(zr)), rr = __builtin_amdgcn_rcpf(1.f + e), er = e * rr;
        const bool msk = diag && (16 * (r >> 3) + 8 * hi + (r & 7)) >= q;
        be[r] = msk ? 0.f : (zr >= 0.f ? rr : er);
        nb[r] = msk ? 1.f : (zr >= 0.f ? er : rr);
    }
    float att[16];
#pragma unroll
    for (int g = 0; g < 2; ++g) {
        float p = 1.f;
#pragma unroll
        for (int i = 7; i >= 0; --i) { att[8 * g + i] = be[8 * g + i] * p; p *= nb[8 * g + i]; }
        nb[8 * g] = p;
    }
    const float T0 = nb[0], T1 = nb[8], P0 = __shfl_xor(T0, 32), P1 = __shfl_xor(T1, 32);
    const float run1 = T1 * P1;
    const float e1 = carry * (hi == 0 ? P1 : 1.f), e0 = carry * run1 * (hi == 0 ? P0 : 1.f);
#pragma unroll
    for (int r = 0; r < 16; ++r) att[r] *= (r < 8 ? e0 : e1);
    carry *= run1 * (T0 * P0);
    u32x4 pa0, pa1;
    pa0.x = cvtpk(att[0], att[1]); pa0.y = cvtpk(att[2], att[3]); pa0.z = cvtpk(att[4], att[5]); pa0.w = cvtpk(att[6], att[7]);
    pa1.x = cvtpk(att[8], att[9]); pa1.y = cvtpk(att[10], att[11]); pa1.z = cvtpk(att[12], att[13]); pa1.w = cvtpk(att[14], att[15]);
    o0 = __builtin_amdgcn_mfma_f32_32x32x16_bf16(vf[0][0], __builtin_bit_cast(bf16x8, pa0), o0, 0, 0, 0);
    o0 = __builtin_amdgcn_mfma_f32_32x32x16_bf16(vf[0][1], __builtin_bit_cast(bf16x8, pa1), o0, 0, 0, 0);
    o1 = __builtin_amdgcn_mfma_f32_32x32x16_bf16(vf[1][0], __builtin_bit_cast(bf16x8, pa0), o1, 0, 0, 0);
    o1 = __builtin_amdgcn_mfma_f32_32x32x16_bf16(vf[1][1], __builtin_bit_cast(bf16x8, pa1), o1, 0, 0, 0);
}
__device__ __forceinline__ void sb_stage(LAS unsigned char* wt, int r, int hi, const f32x16& o0, const f32x16& o1, float rinv) {
#pragma unroll
    for (int a = 0; a < 4; ++a) {
        u32x2 w0; w0.x = cvtpk(o0[4 * a] * rinv, o0[4 * a + 1] * rinv); w0.y = cvtpk(o0[4 * a + 2] * rinv, o0[4 * a + 3] * rinv);
        *(LAS u32x2*)(wt + r * 128 + ((a ^ (r & 7)) * 16) + 8 * hi) = w0;
        u32x2 w1; w1.x = cvtpk(o1[4 * a] * rinv, o1[4 * a + 1] * rinv); w1.y = cvtpk(o1[4 * a + 2] * rinv, o1[4 * a + 3] * rinv);
        *(LAS u32x2*)(wt + r * 128 + (((4 + a) ^ (r & 7)) * 16) + 8 * hi) = w1;
    }
}
__device__ __forceinline__ void attn_unit(const bf16_t* PROJ, const bf16_t* VT, bf16_t* Y, const float* outg, int b, int qb, LAS float* red, int wid, int lane) {
    const int h = wid, q = lane & 31, hi = lane >> 5;
    const int kperm = (q & 19) | ((q & 4) << 1) | ((q & 8) >> 1);
    const size_t rowA = (size_t)b * SEQ + 64 * qb + q;
    bf16x8 qfA[4], qfB[4];
#pragma unroll
    for (int kb = 0; kb < 4; ++kb) { qfA[kb] = *(const bf16x8*)(PROJ + rowA * INW + 1024 + h * 64 + 16 * kb + 8 * hi); qfB[kb] = *(const bf16x8*)(PROJ + (rowA + 32) * INW + 1024 + h * 64 + 16 * kb + 8 * hi); }
    f32x16 oA0, oA1, oB0, oB1;
#pragma unroll
    for (int r = 0; r < 16; ++r) { oA0[r] = 0.f; oA1[r] = 0.f; oB0[r] = 0.f; oB1[r] = 0.f; }
    float carryA = 1.f, carryB = 1.f;
    const bf16_t* Kbase = PROJ + ((size_t)b * SEQ + kperm) * INW + 1536 + h * 64 + 8 * hi;
    const bf16_t* Vbase = VT + (size_t)(h * 64 + q) * M + (size_t)b * SEQ + 8 * hi;
    bf16x8 kf[4], kn[4], vf[2][2];
#define LOADK(KF, kt_) do { _Pragma("unroll") for (int kb = 0; kb < 4; ++kb) KF[kb] = *(const bf16x8*)(Kbase + (size_t)(32 * (kt_)) * INW + 16 * kb); } while (0)
#define LOADV(VF, kt_) do { _Pragma("unroll") for (int d0 = 0; d0 < 2; ++d0) _Pragma("unroll") for (int k2 = 0; k2 < 2; ++k2) VF[d0][k2] = *(const bf16x8*)(Vbase + (size_t)(32 * d0) * M + 32 * (kt_) + 16 * k2); } while (0)
    const int ktop = 2 * qb + 1;
    LOADK(kf, ktop);
    for (int kt = ktop; kt >= 0; --kt) {
        LOADV(vf, kt);
        if (kt > 0) LOADK(kn, kt - 1);
        if (!__all(carryB == 0.f)) sb_tile(kf, qfB, vf, kt == ktop, q, hi, carryB, oB0, oB1);
        if (kt < ktop && !__all(carryA == 0.f)) sb_tile(kf, qfA, vf, kt == ktop - 1, q, hi, carryA, oA0, oA1);
        if (__all(carryA == 0.f && carryB == 0.f)) break;
#pragma unroll
        for (int kb = 0; kb < 4; ++kb) kf[kb] = kn[kb];
    }
#undef LOADK
#undef LOADV
    float ssA = 0.f, ssB = 0.f;
#pragma unroll
    for (int r = 0; r < 16; ++r) { ssA += oA0[r] * oA0[r] + oA1[r] * oA1[r]; ssB += oB0[r] * oB0[r] + oB1[r] * oB1[r]; }
    ssA += __shfl_xor(ssA, 32); ssB += __shfl_xor(ssB, 32);
    if (hi == 0) { red[wid * 64 + q] = ssA; red[wid * 64 + 32 + q] = ssB; }
    __syncthreads();
    float totA = 0.f, totB = 0.f;
#pragma unroll
    for (int w = 0; w < 8; ++w) { totA += red[w * 64 + q]; totB += red[w * 64 + 32 + q]; }
    bf16_t* yp = Y + rowA * DM + 512 + h * 64 + 4 * hi;
    LAS unsigned char* wt = (LAS unsigned char*)red + 2048 + wid * 8192;
    sb_stage(wt, q, hi, oA0, oA1, rsqrtf(totA * (1.f / 512.f) + RMS_EPS));
    sb_stage(wt, 32 + q, hi, oB0, oB1, rsqrtf(totB * (1.f / 512.f) + RMS_EPS));
    { const int rr = lane >> 3, cc = lane & 7;
      bf16_t* yrow = Y + ((size_t)b * SEQ + 64 * qb + rr) * DM + 512 + h * 64 + cc * 8;
#pragma unroll
      for (int j = 0; j < 8; ++j) { const int r = rr + 8 * j; const u32x4 v = *(const LAS u32x4*)(wt + r * 128 + ((cc ^ (r & 7)) * 16)); *(u32x4*)(yrow + (size_t)(8 * j) * DM) = v; } }
    __syncthreads();
}

__device__ __forceinline__ void conv_unit(const bf16_t* PROJ, bf16_t* Y, const float* cw, const float* cb, const float* lg, const float* lb, const float* outg,
                                          int b, int ti, LAS float* hbuf, LAS float* cbuf, int wid, int lane) {
    const int tid = wid * 64 + lane, t0 = 32 * ti;
    float w[31];
#pragma unroll
    for (int j = 0; j < 31; ++j) w[j] = cw[j * 256 + (tid & 255)];
    const float bias = cb[tid & 255];
    {
        u32x4 va[4], ga[4];
#pragma unroll
        for (int k = 0; k < 4; ++k) { const int it = tid + 512 * k, rr = it >> 5, c8 = (it & 31) * 8, t = t0 - 30 + rr;
            if (it < 62 * 32 && t >= 0) { const bf16_t* p = PROJ + ((size_t)b * SEQ + t) * INW + c8; va[k] = *(const u32x4*)p; ga[k] = *(const u32x4*)(p + 256); }
            else { va[k] = (u32x4){0u, 0u, 0u, 0u}; ga[k] = (u32x4){0u, 0u, 0u, 0u}; } }
#pragma unroll
        for (int k = 0; k < 4; ++k) { const int it = tid + 512 * k, rr = it >> 5, c8 = (it & 31) * 8;
            if (it < 62 * 32) {
                f32x4 h0, h1;
                h0[0] = bflo(va[k].x) * sigmoidf_(bflo(ga[k].x)); h0[1] = bfhi(va[k].x) * sigmoidf_(bfhi(ga[k].x));
                h0[2] = bflo(va[k].y) * sigmoidf_(bflo(ga[k].y)); h0[3] = bfhi(va[k].y) * sigmoidf_(bfhi(ga[k].y));
                h1[0] = bflo(va[k].z) * sigmoidf_(bflo(ga[k].z)); h1[1] = bfhi(va[k].z) * sigmoidf_(bfhi(ga[k].z));
                h1[2] = bflo(va[k].w) * sigmoidf_(bflo(ga[k].w)); h1[3] = bfhi(va[k].w) * sigmoidf_(bfhi(ga[k].w));
                *(LAS f32x4*)(hbuf + rr * 256 + c8) = h0; *(LAS f32x4*)(hbuf + rr * 256 + c8 + 4) = h1;
            } }
    }
    __syncthreads();
    {
        const int c = tid & 255, half = tid >> 8;
        float acc[16];
#pragma unroll
        for (int tt = 0; tt < 16; ++tt) acc[tt] = bias;
#pragma unroll
        for (int i = 0; i < 46; ++i) {
            const float v = hbuf[(half * 16 + i) * 256 + c];
#pragma unroll
            for (int tt = 0; tt < 16; ++tt) { const int j = i - tt; if (j >= 0 && j <= 30) acc[tt] += w[j] * v; }
        }
#pragma unroll
        for (int tt = 0; tt < 16; ++tt) cbuf[(half * 16 + tt) * 256 + c] = acc[tt];
    }
    __syncthreads();
    {
        const f32x4 gv = *(const f32x4*)(lg + 4 * lane), bv = *(const f32x4*)(lb + 4 * lane);
        f32x4 x[4]; float sv[8];
#pragma unroll
        for (int k = 0; k < 4; ++k) { x[k] = *(LAS f32x4*)(cbuf + (wid + 8 * k) * 256 + 4 * lane);
            sv[2 * k] = (x[k][0] + x[k][1]) + (x[k][2] + x[k][3]); sv[2 * k + 1] = dot4(x[k]); }
        wave_sum_n8(sv);
        f32x4 sl[4]; float rs[4];
#pragma unroll
        for (int k = 0; k < 4; ++k) {
            const float mean = sv[2 * k] * (1.f / 256.f);
            const float rstd = rsqrtf(fmaxf(sv[2 * k + 1] * (1.f / 256.f) - mean * mean, 0.f) + LN_EPS);
#pragma unroll
            for (int j = 0; j < 4; ++j) { const float y = (x[k][j] - mean) * rstd * gv[j] + bv[j]; sl[k][j] = y * sigmoidf_(y); }
            rs[k] = dot4(sl[k]);
        }
        wave_sum_n4(rs);
#pragma unroll
        for (int k = 0; k < 4; ++k) {
            const float rinv = rsqrtf(rs[k] * (1.f / 256.f) + RMS_EPS);
            u32x2 o; o.x = cvtpk(sl[k][0] * rinv, sl[k][1] * rinv); o.y = cvtpk(sl[k][2] * rinv, sl[k][3] * rinv);
            *(u32x2*)(Y + ((size_t)b * SEQ + t0 + wid + 8 * k) * DM + 4 * lane) = o;
        }
    }
    __syncthreads();
}

constexpr int VT_P = 136;
__device__ __forceinline__ void sg_unit(const bf16_t* PROJ, bf16_t* Y, const bf16_t* WSG, const float* sgb, const float* lg, const float* lb, const float* outg,
                                        int b, int n, int th, LAS bf16_t* vT, LAS float* red, int wid, int lane) {
    const int smax = 64 * (th + 1);
    const size_t row0 = (size_t)b * SEQ + 128 * n;
    {
        const f32x4 gv = *(const f32x4*)(lg + 4 * lane), bv = *(const f32x4*)(lb + 4 * lane);
        const int ntrip = smax >> 5;
        u32x2 raw[4][4];
#pragma unroll
        for (int i = 0; i < 4; ++i) if (i < ntrip) {
#pragma unroll
            for (int k = 0; k < 4; ++k) raw[i][k] = *(const u32x2*)(PROJ + (row0 + 32 * i + 4 * wid + k) * INW + 768 + 4 * lane); }
#pragma unroll
        for (int i = 0; i < 4; ++i) if (i < ntrip) {
            f32x4 x[4]; float sv[8];
#pragma unroll
            for (int k = 0; k < 4; ++k) { x[k] = (f32x4){gelu_erf(bflo(raw[i][k].x)), gelu_erf(bfhi(raw[i][k].x)), gelu_erf(bflo(raw[i][k].y)), gelu_erf(bfhi(raw[i][k].y))};
                sv[2 * k] = (x[k][0] + x[k][1]) + (x[k][2] + x[k][3]); sv[2 * k + 1] = dot4(x[k]); }
            wave_sum_n8(sv);
#pragma unroll
            for (int k = 0; k < 4; ++k) {
                const float mean = sv[2 * k] * (1.f / 256.f);
                const float rstd = rsqrtf(fmaxf(sv[2 * k + 1] * (1.f / 256.f) - mean * mean, 0.f) + LN_EPS);
#pragma unroll
                for (int j = 0; j < 4; ++j) x[k][j] = (x[k][j] - mean) * rstd * gv[j] + bv[j];
            }
#pragma unroll
            for (int j = 0; j < 4; ++j) { u32x2 w; w.x = cvtpk(x[0][j], x[1][j]); w.y = cvtpk(x[2][j], x[3][j]);
                *(LAS u32x2*)(vT + (4 * lane + j) * VT_P + 32 * i + 4 * wid) = w; }
        }
    }
    __syncthreads();
    const int nt2 = wid & 1, cq = wid >> 1, t31 = lane & 31, hi = lane >> 5;
    const int tl = 64 * th + 32 * nt2 + t31;
    f32x16 acc0, acc1;
#pragma unroll
    for (int r = 0; r < 16; ++r) { acc0[r] = 0.f; acc1[r] = 0.f; }
    const int nkb = 2 * (2 * th + nt2 + 1);
    const bf16_t* wrow = WSG + ((size_t)cq * 128 + tl) * 128 + 8 * hi;
    const LAS bf16_t* a0 = vT + (64 * cq + t31) * VT_P + 8 * hi;
    bf16x8 Bf[8];
#pragma unroll
    for (int kb = 0; kb < 8; ++kb) if (kb < nkb) Bf[kb] = *(const bf16x8*)(wrow + 16 * kb);
    const bf16_t* up = PROJ + (row0 + tl) * INW + 512 + 64 * cq + 4 * hi;
    u32x2 ur0[4], ur1[4];
#pragma unroll
    for (int a = 0; a < 4; ++a) { ur0[a] = *(const u32x2*)(up + 8 * a); ur1[a] = *(const u32x2*)(up + 32 + 8 * a); }
    const float bias = sgb[cq * 128 + tl];
#pragma unroll
    for (int kb = 0; kb < 8; ++kb) if (kb < nkb) {
        const bf16x8 A0 = *(const LAS bf16x8*)(a0 + 16 * kb), A1 = *(const LAS bf16x8*)(a0 + 32 * VT_P + 16 * kb);
        acc0 = __builtin_amdgcn_mfma_f32_32x32x16_bf16(A0, Bf[kb], acc0, 0, 0, 0);
        acc1 = __builtin_amdgcn_mfma_f32_32x32x16_bf16(A1, Bf[kb], acc1, 0, 0, 0);
    }
    float ss = 0.f;
#pragma unroll
    for (int a = 0; a < 4; ++a) {
        const u32x2 r0 = ur0[a], r1 = ur1[a];
        acc0[4 * a + 0] = gelu_erf(bflo(r0.x)) * (acc0[4 * a + 0] + bias); acc0[4 * a + 1] = gelu_erf(bfhi(r0.x)) * (acc0[4 * a + 1] + bias);
        acc0[4 * a + 2] = gelu_erf(bflo(r0.y)) * (acc0[4 * a + 2] + bias); acc0[4 * a + 3] = gelu_erf(bfhi(r0.y)) * (acc0[4 * a + 3] + bias);
        acc1[4 * a + 0] = gelu_erf(bflo(r1.x)) * (acc1[4 * a + 0] + bias); acc1[4 * a + 1] = gelu_erf(bfhi(r1.x)) * (acc1[4 * a + 1] + bias);
        acc1[4 * a + 2] = gelu_erf(bflo(r1.y)) * (acc1[4 * a + 2] + bias); acc1[4 * a + 3] = gelu_erf(bfhi(r1.y)) * (acc1[4 * a + 3] + bias);
    }
#pragma unroll
    for (int r = 0; r < 16; ++r) ss += acc0[r] * acc0[r] + acc1[r] * acc1[r];
    ss += __shfl_xor(ss, 32);
    if (hi == 0) red[cq * 64 + 32 * nt2 + t31] = ss;
    __syncthreads();
    const int tloc = 32 * nt2 + t31;
    const float rinv = rsqrtf(((red[tloc] + red[64 + tloc]) + (red[128 + tloc] + red[192 + tloc])) * (1.f / 256.f) + RMS_EPS);
    bf16_t* yp = Y + (row0 + tl) * DM + 256 + 64 * cq + 4 * hi;
#pragma unroll
    for (int a = 0; a < 4; ++a) {
        u32x2 o; o.x = cvtpk(acc0[4 * a] * rinv, acc0[4 * a + 1] * rinv); o.y = cvtpk(acc0[4 * a + 2] * rinv, acc0[4 * a + 3] * rinv);
        *(u32x2*)(yp + 8 * a) = o;
        u32x2 p; p.x = cvtpk(acc1[4 * a] * rinv, acc1[4 * a + 1] * rinv); p.y = cvtpk(acc1[4 * a + 2] * rinv, acc1[4 * a + 3] * rinv);
        *(u32x2*)(yp + 32 + 8 * a) = p;
    }
    __syncthreads();
}

#ifdef PROBE_BARX2
#define GSYNC() do { xcd_barrier(bar); xcd_barrier(bar); } while (0)
#else
#define GSYNC() xcd_barrier(bar)
#endif
struct Args { const float* in[18]; float* out; unsigned char* ws; };
__device__ __forceinline__ void convert_item(const Args& a, unsigned char* ws, int l, int r, LAS float* scr, int lane) {
    bf16_t* wl = (bf16_t*)(ws + WS_W + (size_t)l * W_LAYER);
    if (r < 1280) { const int kb = r / 80, nb = r - kb * 80, n0 = 32 * nb, pn = n0 >> 8, p = n0 & 255, bj = p >> 7, wc = (p >> 5) & 3;
        transpose_item(a.in[2] + (size_t)l * DM * INW, DM, INW, wl + WOFF_IN / 2, a.in[1] + l * DM, scr, kb, n0, 256 * inproj_ltile(pn) + 64 * wc + 32 * bj, lane); }
    else if (r < 1792) { r -= 1280; const int kb = r >> 5, nb = r & 31;
        transpose_item(a.in[14] + (size_t)l * DM * DM, DM, DM, wl + WOFF_OUT / 2, a.in[13] + l * DM, scr, kb, 32 * nb, 32 * nb, lane); }
    else if (r < 4608) { r -= 1792; const int kb = r / 176, nb = r - kb * 176, n0 = 32 * nb, pn = n0 >> 8, p = n0 & 255, bj = p >> 7, q = (p >> 5) & 3;
        transpose_item(a.in[16] + (size_t)l * DM * GUW, DM, GUW, wl + WOFF_GU / 2, a.in[15] + l * DM, scr, kb, n0, (bj ? FFH : 0) + 128 * pn + 32 * q, lane); }
    else { r -= 4608; const int kb = r >> 5, nb = r & 31;
        transpose_item(a.in[17] + (size_t)l * FFH * DM, FFH, DM, wl + WOFF_DN / 2, nullptr, scr, kb, 32 * nb, 32 * nb, lane); }
}
__global__ void __launch_bounds__(512, 2) mega_fwd(Args a) {
    extern __shared__ __attribute__((aligned(16))) unsigned char lds_raw[];
    LAS unsigned char* lds = (LAS unsigned char*)lds_raw;
    const int tid = threadIdx.x, lane = tid & 63, wid = __builtin_amdgcn_readfirstlane(tid >> 6);
    const int G = gridDim.x, bx = blockIdx.x, gw = bx * 8 + wid, NGW = G * 8;
    unsigned char* ws = a.ws;
    const float* x_in = a.in[0];
    float* SSA = (float*)(ws + WS_SS); float* SSB = (float*)(ws + WS_SSB);
    bf16_t* WSG = (bf16_t*)(ws + WS_WSG);
    bf16_t* XB = (bf16_t*)(ws + WS_XB); bf16_t* Yb = (bf16_t*)(ws + WS_Y); bf16_t* PROJ = (bf16_t*)(ws + WS_PROJ); bf16_t* VT = (bf16_t*)(ws + WS_VT); bf16_t* Hb = (bf16_t*)(ws + WS_H);
    float* out = a.out;
    volatile LAS unsigned* bst = (volatile LAS unsigned*)(lds + LDS_BYTES - 16);
    if (tid < 4) bst[tid] = 0u;
    __syncthreads();
    XcdBarrier bar = xcd_barrier_post((unsigned*)(ws + WS_BAR), bst);
    if (a.ws == nullptr) cg::this_grid().sync();

#ifdef PROBE_P0X2
    for (int rep_ = 0; rep_ < 2; ++rep_)
#endif
    {
        LAS float* scr = (LAS float*)(lds + wid * 8448);
        for (int it = gw; it < 6016; it += NGW) convert_item(a, ws, 0, it, scr, lane);
        for (int m = gw; m < M; m += NGW) {
            const f32x4* xr = (const f32x4*)(x_in + (size_t)m * DM) + lane; float s = 0.f;
            u32x2* o = (u32x2*)(XB + (size_t)m * DM) + lane;
#pragma unroll
            for (int j = 0; j < 4; ++j) { const f32x4 v = __builtin_nontemporal_load(xr + 64 * j); s += dot4(v); u32x2 w; w.x = cvtpk(v[0], v[1]); w.y = cvtpk(v[2], v[3]); o[64 * j] = w; }
            s = wave_sum(s); if (lane < 16) SSB[(size_t)m * 16 + lane] = lane == 0 ? s : 0.f;
        }
        for (int i = bx * 512 + tid; i < DEPTH * 4 * 128 * 128; i += G * 512) { const int s = i & 127, t = (i >> 7) & 127; WSG[i] = f2bf(s <= t ? a.in[9][i] : 0.f); }
    }
    GSYNC();

#define SPARE_CONVERT(lo, hi) do { if (l + 1 < DEPTH) { const bool half_ = (G == 256); if (!half_ || bx >= 128) { const int nw_ = (half_ ? 128 : G) * 8, w0_ = ((half_ ? bx - 128 : bx) * 8 + wid); \
        int lane_c = threadIdx.x & 63; asm volatile("" : "+v"(lane_c)); LAS float* scr_ = (LAS float*)(lds + wid * 8448); \
        for (int it = (lo) + w0_; it < (hi); it += nw_) convert_item(a, ws, l + 1, it, scr_, lane_c); } } } while (0)
    for (int l = 0; l < DEPTH; ++l) {
        const bf16_t* wl = (const bf16_t*)(ws + WS_W + (size_t)l * W_LAYER);
#ifdef PROBE_P1X2
        for (int rep_ = 0; rep_ < 2; ++rep_)
#endif
        { pg8::Gemm g{XB, wl + WOFF_IN / 2, M, INW, DM}; pg8::StaticOrder S; S.init(M, INW, G, bx);
          EpiInProj E{PROJ, VT, SSB, a.in[11] + l * 64, a.in[12] + l * 64};
          pg8::gemm_phase<EpiInProj, pg8::StaticOrder, true, true>(lds, g, S, E); }
        SPARE_CONVERT(0, 3008);
        GSYNC();
#ifdef PROBE_P2X2
        for (int rep_ = 0; rep_ < 2; ++rep_)
#endif
        {
            const float* outg = a.in[13] + l * DM;
            int lane_l = threadIdx.x & 63; asm volatile("" : "+v"(lane_l)); const int lane = lane_l;
#ifdef DIAG_FILL
            for (size_t i = (size_t)bx * 512 + threadIdx.x; i < (size_t)M * DM / 8; i += (size_t)G * 512) { const size_t r = i >> 7, c = (i & 127) * 8; *(u32x4*)(Yb + r * DM + c) = *(const u32x4*)(PROJ + r * INW + c); }
            GSYNC();
#endif
#ifndef DIAG_NOATTN
#ifdef PROBE_ATTNX2
            for (int rep2_ = 0; rep2_ < 2; ++rep2_)
#endif
            for (int p = bx; p < 256; p += G) {
                const int b = p & 7, s = p >> 3;
                attn_unit(PROJ, VT, Yb, outg + 512, b, s, (LAS float*)lds, wid, lane);
            }
#endif
#ifndef DIAG_NOCONV
#ifdef PROBE_CONVX2
            for (int rep2_ = 0; rep2_ < 2; ++rep2_)
#endif
            for (int id = bx; id < 512; id += G)
                conv_unit(PROJ, Yb, a.in[3] + l * 31 * 256, a.in[4] + l * 256, a.in[5] + l * 256, a.in[6] + l * 256, outg, id & 7, (id >> 3) & 63, (LAS float*)lds, (LAS float*)(lds + 63488), wid, lane);
#endif
#ifndef DIAG_NOSG
#ifdef PROBE_SGX2
            for (int rep2_ = 0; rep2_ < 2; ++rep2_)
#endif
            for (int id = bx; id < 256; id += G)
                sg_unit(PROJ, Yb, WSG + (size_t)l * 4 * 128 * 128, a.in[10] + l * 512, a.in[7] + l * 256, a.in[8] + l * 256, outg + 256, id & 7, (id >> 4) & 15, (id >> 3) & 1,
                        (LAS bf16_t*)lds, (LAS float*)(lds + 69632), wid, lane);
#endif
        }
        GSYNC();
        { pg8::Gemm g{Yb, wl + WOFF_OUT / 2, M, DM, DM}; pg8::StaticOrder S; S.init(M, DM, G, bx);
          EpiRes E{l == 0 ? x_in : nullptr, nullptr, XB, SSA};
          pg8::gemm_phase<EpiRes, pg8::StaticOrder, true, true>(lds, g, S, E); }
        GSYNC();
#ifdef PROBE_P4X2
        for (int rep_ = 0; rep_ < 2; ++rep_)
#endif
        { pg8::Gemm g{XB, wl + WOFF_GU / 2, M, GUW, DM}; pg8::StaticOrder S; S.init(M, GUW, G, bx);
          EpiSwiglu E{Hb, SSA};
          pg8::gemm_phase<EpiSwiglu, pg8::StaticOrder, true, true>(lds, g, S, E); }
        SPARE_CONVERT(3008, 6016);
        GSYNC();
        { pg8::Gemm g{Hb, wl + WOFF_DN / 2, M, DM, FFH}; pg8::StaticOrder S; S.init(M, DM, G, bx);
          const bool last = (l == DEPTH - 1);
          EpiRes E{nullptr, last ? out : nullptr, XB, SSB};
          pg8::gemm_phase<EpiRes, pg8::StaticOrder, true, true>(lds, g, S, E); }
        if (l + 1 < DEPTH) GSYNC();
    }
}

extern "C" void kernel_launch(void* const* d_in, const int* in_sizes, int n_in, void* d_out, int out_size, void* d_ws, size_t ws_size, hipStream_t stream) {
    static int grid = 0;
    if (grid == 0) {
        if (n_in != 18 || in_sizes[0] != M * DM || out_size != M * DM || ws_size < WS_END) { fprintf(stderr, "kernel_launch: unexpected shapes (n_in %d, in0 %d, out %d, ws %zu)\n", n_in, n_in > 0 ? in_sizes[0] : -1, out_size, ws_size); grid = -1; return; }
        int dev = 0, cus = 0, per_cu = 0;
        if (hipGetDevice(&dev) != hipSuccess || hipDeviceGetAttribute(&cus, hipDeviceAttributeMultiprocessorCount, dev) != hipSuccess) { grid = -1; return; }
        if (hipFuncSetAttribute((const void*)mega_fwd, hipFuncAttributeMaxDynamicSharedMemorySize, LDS_BYTES) != hipSuccess) { fprintf(stderr, "kernel_launch: hipFuncSetAttribute failed\n"); grid = -1; return; }
        if (hipOccupancyMaxActiveBlocksPerMultiprocessor(&per_cu, (const void*)mega_fwd, 512, LDS_BYTES) != hipSuccess || per_cu < 1) { fprintf(stderr, "kernel_launch: occupancy query gave %d\n", per_cu); per_cu = 1; }
        (void)hipGetLastError();
        grid = cus * per_cu;
        fprintf(stderr, "kernel_launch: grid %d (%d CUs x %d)\n", grid, cus, per_cu);
    }
    if (grid < 0) return;
    if (hipMemsetAsync((char*)d_ws + WS_BAR, 0, BAR_BYTES, stream) != hipSuccess) { fprintf(stderr, "kernel_launch: memset failed\n"); return; }
    Args a{};
    for (int i = 0; i < 18; ++i) a.in[i] = (const float*)d_in[i];
    a.out = (float*)d_out; a.ws = (unsigned char*)d_ws;
    void* args[] = {&a};
    hipError_t e = hipLaunchCooperativeKernel((const void*)mega_fwd, dim3(grid), dim3(512), args, LDS_BYTES, stream);
    if (e != hipSuccess) fprintf(stderr, "kernel_launch: cooperative launch failed: %s (grid %d)\n", hipGetErrorString(e), grid);
}
```

```cpp
#include <hip/hip_runtime.h>
#include <hip/hip_cooperative_groups.h>
#include <cstdio>
#include <cstdint>
namespace cg = cooperative_groups;
namespace pg8 {
#define PG8_LAS __attribute__((address_space(3)))
typedef unsigned short bf16_t;
typedef short bf16x8 __attribute__((ext_vector_type(8)));
typedef float f32x4 __attribute__((ext_vector_type(4)));
typedef unsigned u32x4 __attribute__((ext_vector_type(4)));
constexpr int BM = 256, BK = 64, HALF = 128, HTB = HALF * BK * 2  , STAGE_BYTES = 8 * HTB, NXCD = 8, WGM = 8;

__host__ __device__ __forceinline__ int lds_byte(int r, int c) { const int st = (r >> 4) * 2 + (c >> 5), rr = r & 15, cc = c & 31, ob = rr * 64 + cc * 2; return st * 1024 + (ob ^ (((ob >> 9) & 1) << 5)); }
__host__ __device__ __forceinline__ void stage_rc(int b, int& R, int& C) { const int st = b / 1024, sb = b % 1024, swz = sb ^ (((sb >> 9) & 1) << 5); R = (st >> 1) * 16 + swz / 64; C = (st & 1) * 32 + (swz % 64) / 2; }
__host__ __device__ __forceinline__ int perm32(int rho) { const int n = rho >> 4, i = rho & 15; return 8 * (i >> 2) + 4 * n + (i & 3); }

struct Unit { int pm, pn; };
struct Gemm { const bf16_t* A; const bf16_t* Bt; int M, N, K; };

struct StaticOrder {
    int nM, nN, nwg, G, c;
    __host__ __device__ void init(int M, int N, int G_, int c_) { nM = M / BM; nN = N / BM; nwg = nM * nN; G = G_; c = c_; }
    __host__ __device__ bool next(int i, Unit& u) const {
        const long L = (long)i * G + c; if (L >= nwg) return false;
        int wgid = (int)L; { const int q = nwg / NXCD, r = nwg % NXCD, xcd = wgid % NXCD, off = wgid / NXCD; wgid = (xcd < r ? xcd * (q + 1) : r * (q + 1) + (xcd - r) * q) + off; }
        const int nig = WGM * nN, gid = wgid / nig, fm = gid * WGM, gsz = (nM - fm) < WGM ? (nM - fm) : WGM;
        u.pm = fm + ((wgid % nig) % gsz); u.pn = (wgid % nig) / gsz; return true;
    }
    __device__ __forceinline__ void a_ready(const Unit&) const {}
    __device__ __forceinline__ void done(const Unit&) const {}
};

__device__ __forceinline__ unsigned cvt_pk_bf16(float lo, float hi) { unsigned r; asm volatile("v_cvt_pk_bf16_f32 %0, %1, %2" : "=v"(r) : "v"(lo), "v"(hi)); return r; }
typedef float f32x2 __attribute__((ext_vector_type(2)));
template <class Epi, class Sched, bool ALIGN_EPI = false, bool SP2 = false>
__device__ __forceinline__ void gemm_phase(PG8_LAS unsigned char* lds, const Gemm g, const Sched& S, const Epi& E) {
    int tid_l = threadIdx.x; asm volatile("" : "+v"(tid_l)); const int tid = tid_l, wid = __builtin_amdgcn_readfirstlane(tid >> 6), lane = tid & 63, wr = wid >> 2, wc = wid & 3, fr = lane & 15, fq = lane >> 4;
    const int K = g.K, nt = K / BK;
    unsigned voffA[2], voffB[2];
#pragma unroll
    for (int i = 0; i < 2; ++i) { int R, C; stage_rc(tid * 16 + i * 8192, R, C); const int Rb = Epi::PERM ? ((R & ~31) + perm32(R & 31)) : R;
        voffA[i] = (unsigned)(R * K + C) * 2u; voffB[i] = (unsigned)(Rb * K + C) * 2u; }
    const size_t kstep = (size_t)(BK * 2);
    const size_t hstep = (size_t)HALF * K * 2;
    const size_t tstep = 2 * hstep;
    const unsigned ldsw = (unsigned)wid * 1024u;
    const int aoff = lds_byte(wr * 64 + fr, fq * 8), boff = lds_byte(wc * 32 + fr, fq * 8);
#define PG8_SA(b, h) (((b) * 2 + (h)) * HTB)
#define PG8_SB(b, h) ((4 + (b) * 2 + (h)) * HTB)
#define PG8_STAGE(bufoff, gbase, voff) do { _Pragma("unroll") for (int _i = 0; _i < 2; ++_i) \
        __builtin_amdgcn_global_load_lds((const unsigned*)((const char*)(gbase) + (voff)[_i]), (PG8_LAS unsigned*)(lds + (bufoff) + ldsw + _i * 8192), 16, 0, 0); } while (0)
#define PG8_LDA(dst, b, h) do { _Pragma("unroll") for (int m = 0; m < 4; ++m) _Pragma("unroll") for (int k = 0; k < 2; ++k) dst[m][k] = *(const PG8_LAS bf16x8*)(lds + PG8_SA(b, h) + aoff + m * 2048 + k * 1024); } while (0)
#define PG8_LDB(dst, b, h) do { _Pragma("unroll") for (int n = 0; n < 2; ++n) _Pragma("unroll") for (int k = 0; k < 2; ++k) dst[n][k] = *(const PG8_LAS bf16x8*)(lds + PG8_SB(b, h) + boff + n * 2048 + k * 1024); } while (0)
#define PG8_MMA(ai, bj, At, Bt) do { __builtin_amdgcn_s_setprio(1); _Pragma("unroll") for (int m = 0; m < 4; ++m) _Pragma("unroll") for (int n = 0; n < 2; ++n) _Pragma("unroll") for (int k = 0; k < 2; ++k) \
        acc[ai][bj][m][n] = __builtin_amdgcn_mfma_f32_16x16x32_bf16(Bt[n][k], At[m][k], acc[ai][bj][m][n], 0, 0, 0); __builtin_amdgcn_s_setprio(0); } while (0)
#define PG8_WAIT_V(n) asm volatile("s_waitcnt vmcnt(" #n ")" ::: "memory")
#define PG8_WAIT_L(n) asm volatile("s_waitcnt lgkmcnt(" #n ")" ::: "memory")
#define PG8_BAR __builtin_amdgcn_s_barrier()
#define PG8_SCHED __builtin_amdgcn_sched_barrier(0)
    Unit cur, nxt; int ui = 0;
    if (!S.next(0, cur)) return;
    f32x4 acc[2][2][4][2];
#pragma unroll
    for (int a = 0; a < 2; ++a)
#pragma unroll
        for (int b = 0; b < 2; ++b)
#pragma unroll
            for (int m = 0; m < 4; ++m)
#pragma unroll
                for (int n = 0; n < 2; ++n) acc[a][b][m][n] = (f32x4){0.f, 0.f, 0.f, 0.f};
    bf16x8 At[4][2], B0[2][2], B1[2][2];
    const char* cA = (const char*)g.A + (size_t)cur.pm * tstep; const char* cB = (const char*)g.Bt + (size_t)cur.pn * tstep;
    S.a_ready(cur);
    if constexpr (SP2) {
        PG8_STAGE(PG8_SB(0, 0), cB, voffB); PG8_STAGE(PG8_SB(0, 1), cB + hstep, voffB); PG8_STAGE(PG8_SA(0, 0), cA, voffA); PG8_STAGE(PG8_SA(0, 1), cA + hstep, voffA);
        if (wr == 1) PG8_BAR;
        PG8_WAIT_V(2); PG8_BAR;
        PG8_STAGE(PG8_SB(1, 0), cB + kstep, voffB); PG8_STAGE(PG8_SA(1, 0), cA + kstep, voffA); PG8_STAGE(PG8_SB(1, 1), cB + hstep + kstep, voffB);
        PG8_WAIT_V(6); PG8_BAR;
    } else {
        PG8_STAGE(PG8_SB(0, 0), cB, voffB); PG8_STAGE(PG8_SA(0, 0), cA, voffA); PG8_STAGE(PG8_SB(0, 1), cB + hstep, voffB); PG8_STAGE(PG8_SA(0, 1), cA + hstep, voffA);
        if (wr == 1) PG8_BAR;
        PG8_WAIT_V(4); PG8_BAR;
        PG8_STAGE(PG8_SB(1, 0), cB + kstep, voffB); PG8_STAGE(PG8_SA(1, 0), cA + kstep, voffA); PG8_STAGE(PG8_SB(1, 1), cB + hstep + kstep, voffB);
        PG8_WAIT_V(6); PG8_BAR;
    }
    for (;;) {
        const bool has_next = S.next(ui + 1, nxt);
        const char* nA = has_next ? (const char*)g.A + (size_t)nxt.pm * tstep : cA; const char* nB = has_next ? (const char*)g.Bt + (size_t)nxt.pn * tstep : cB;
        asm volatile(".p2align 6");
        for (int t = 0; t < nt; t += 2) {
            const bool last = (t == nt - 2);
            const char* a1 = cA + (size_t)(t + 1) * kstep;
            const char* a2 = last ? nA : cA + (size_t)(t + 2) * kstep; const char* b2 = last ? nB : cB + (size_t)(t + 2) * kstep;
            const char* a3 = a2 + kstep; const char* b3 = b2 + kstep;
            if (last && has_next) S.a_ready(nxt);
            if constexpr (SP2) {
            PG8_LDB(B0, 0, 0); PG8_LDB(B1, 0, 1); PG8_SCHED; PG8_LDA(At, 0, 0); PG8_STAGE(PG8_SA(1, 1), a1 + hstep, voffA);
            PG8_WAIT_V(8); PG8_WAIT_L(0); PG8_BAR; PG8_MMA(0, 0, At, B0); PG8_MMA(0, 1, At, B1); PG8_BAR; PG8_SCHED;
            PG8_LDA(At, 0, 1); PG8_STAGE(PG8_SB(0, 0), b2, voffB); PG8_STAGE(PG8_SB(0, 1), b2 + hstep, voffB); PG8_STAGE(PG8_SA(0, 0), a2, voffA);
            PG8_WAIT_V(8); PG8_WAIT_L(0); PG8_BAR; PG8_MMA(1, 0, At, B0); PG8_MMA(1, 1, At, B1); PG8_BAR; PG8_SCHED;
            PG8_LDB(B0, 1, 0); PG8_LDB(B1, 1, 1); PG8_SCHED; PG8_LDA(At, 1, 0); PG8_STAGE(PG8_SA(0, 1), a2 + hstep, voffA);
            PG8_WAIT_V(8); PG8_WAIT_L(0); PG8_BAR; PG8_MMA(0, 0, At, B0); PG8_MMA(0, 1, At, B1); PG8_BAR; PG8_SCHED;
            PG8_LDA(At, 1, 1); PG8_STAGE(PG8_SB(1, 0), b3, voffB); PG8_STAGE(PG8_SB(1, 1), b3 + hstep, voffB); PG8_STAGE(PG8_SA(1, 0), a3, voffA);
            PG8_WAIT_V(8); PG8_WAIT_L(0); PG8_BAR; PG8_MMA(1, 0, At, B0); PG8_MMA(1, 1, At, B1); PG8_BAR; PG8_SCHED;
            } else {
            PG8_LDB(B0, 0, 0); PG8_SCHED; PG8_LDA(At, 0, 0); PG8_STAGE(PG8_SA(1, 1), a1 + hstep, voffA);
            PG8_WAIT_L(8); PG8_BAR; PG8_WAIT_L(0); PG8_MMA(0, 0, At, B0); PG8_BAR; PG8_SCHED;
            PG8_LDB(B1, 0, 1); PG8_STAGE(PG8_SB(0, 0), b2, voffB);
            PG8_BAR; PG8_WAIT_L(0); PG8_MMA(0, 1, At, B1); PG8_BAR;
            PG8_LDA(At, 0, 1); PG8_STAGE(PG8_SA(0, 0), a2, voffA);
            PG8_BAR; PG8_WAIT_L(0); PG8_MMA(1, 0, At, B0); PG8_BAR; PG8_SCHED;
            PG8_STAGE(PG8_SB(0, 1), b2 + hstep, voffB);
            PG8_WAIT_V(6); PG8_BAR; PG8_MMA(1, 1, At, B1); PG8_BAR;
            PG8_LDB(B0, 1, 0); PG8_SCHED; PG8_LDA(At, 1, 0); PG8_STAGE(PG8_SA(0, 1), a2 + hstep, voffA);
            PG8_WAIT_L(8); PG8_BAR; PG8_WAIT_L(0); PG8_MMA(0, 0, At, B0); PG8_BAR; PG8_SCHED;
            PG8_LDB(B1, 1, 1); PG8_STAGE(PG8_SB(1, 0), b3, voffB);
            PG8_BAR; PG8_WAIT_L(0); PG8_MMA(0, 1, At, B1); PG8_BAR;
            PG8_LDA(At, 1, 1); PG8_STAGE(PG8_SA(1, 0), a3, voffA);
            PG8_BAR; PG8_WAIT_L(0); PG8_MMA(1, 0, At, B0); PG8_BAR; PG8_SCHED;
            PG8_STAGE(PG8_SB(1, 1), b3 + hstep, voffB);
            PG8_WAIT_V(6); PG8_BAR; PG8_MMA(1, 1, At, B1); PG8_BAR;
            }
        }
        if constexpr (ALIGN_EPI) { if (wr == 0) PG8_BAR; }
        if constexpr (!Epi::AFTER_DRAIN) { E(acc, cur, wr, wc, fr, fq); S.done(cur); }
        if (!has_next) break;
#pragma unroll
        for (int a = 0; a < 2; ++a)
#pragma unroll
            for (int b = 0; b < 2; ++b)
#pragma unroll
                for (int m = 0; m < 4; ++m)
#pragma unroll
                    for (int n = 0; n < 2; ++n) acc[a][b][m][n] = (f32x4){0.f, 0.f, 0.f, 0.f};
        cur = nxt; cA = nA; cB = nB; ++ui;
        if constexpr (ALIGN_EPI) { if (wr == 1) PG8_BAR; }
    }
    PG8_WAIT_V(0);
    if constexpr (!ALIGN_EPI) { if (wr == 0) PG8_BAR; }
    PG8_BAR;
    if constexpr (Epi::AFTER_DRAIN) { E.fused(acc, cur, wr, wc, fr, fq, lds, wid, lane); S.done(cur); }
#undef PG8_SA
#undef PG8_SB
#undef PG8_STAGE
#undef PG8_LDA
#undef PG8_LDB
#undef PG8_MMA
#undef PG8_WAIT_V
#undef PG8_WAIT_L
#undef PG8_BAR
#undef PG8_SCHED
}
}
#define GAS __attribute__((address_space(1)))
#define LAS __attribute__((address_space(3)))
#define RLX_AGENT __ATOMIC_RELAXED, __HIP_MEMORY_SCOPE_AGENT
#define LDS_WAIT() asm volatile("s_waitcnt lgkmcnt(0)" ::: "memory")
#define VM_WAIT() asm volatile("s_waitcnt vmcnt(0)" ::: "memory")
__device__ __forceinline__ unsigned long long rt() { return __builtin_amdgcn_s_memrealtime(); }
#define XB_TMO      128
#define XB_XCNT(j)  (256  + 64 * (j))
#define XB_XSUB(j)  (1280 + 64 * (j))
#define XB_XGEN(j)  (2304 + 64 * (j))
#define XB_TOP      3328
#define XB_TOPGEN   3392
#define XCD_BAR_WORDS 3456
#define XB_SPIN_CAP (1u << 18)

__device__ __forceinline__ unsigned xb_ld(unsigned* p)              { return __hip_atomic_load(p, __ATOMIC_RELAXED, __HIP_MEMORY_SCOPE_AGENT); }
__device__ __forceinline__ unsigned xb_add(unsigned* p, unsigned v) { return __hip_atomic_fetch_add(p, v, __ATOMIC_RELAXED, __HIP_MEMORY_SCOPE_AGENT); }
__device__ __forceinline__ unsigned xb_xcc_id() { return (unsigned)__builtin_amdgcn_s_getreg((3 << 11) | 20) & 0xFu; }
#define XB_SPIN(cond, bar) do { unsigned _sp = 0; while (cond) { __builtin_amdgcn_s_sleep(1); \
    if ((++_sp & 255u) == 0u) { if (xb_ld(&(bar)[XB_TMO])) break; if (_sp > XB_SPIN_CAP) { atomicAdd(&(bar)[XB_TMO], 1u); break; } } } } while (0)

struct XcdBarrier {
    unsigned* bar; unsigned x;
    volatile LAS unsigned* st;
};

__device__ __forceinline__ XcdBarrier xcd_barrier_post(unsigned* bar, volatile LAS unsigned* st) {
    XcdBarrier b; b.bar = bar; b.x = xb_xcc_id(); b.st = st;
    if (threadIdx.x == 0) (void)xb_add(&bar[XB_XCNT(b.x)], 1u);
    return b;
}
__device__ __forceinline__ void xcd_barrier_complete(unsigned* bar, unsigned x, unsigned& nloc, unsigned& nx) {
    const unsigned G = gridDim.x * gridDim.y * gridDim.z;
    unsigned sum, cnt, mine, sp = 0u;
    for (;;) {
        sum = 0u; cnt = 0u; mine = 0u;
#pragma unroll
        for (unsigned j = 0; j < 16; ++j) { const unsigned c = xb_ld(&bar[XB_XCNT(j)]); sum += c; cnt += (c > 0u) ? 1u : 0u; mine = (j == x) ? c : mine; }
        if (sum == G) break;
        __builtin_amdgcn_s_sleep(1);
        if ((++sp & 255u) == 0u) { if (xb_ld(&bar[XB_TMO])) break; if (sp > XB_SPIN_CAP) { atomicAdd(&bar[XB_TMO], 1u); break; } }
    }
    nloc = mine > 0u ? mine : 1u; nx = cnt > 0u ? cnt : 1u;
}

__device__ __forceinline__ void xcd_barrier(const XcdBarrier& b) {
    asm volatile("s_waitcnt vmcnt(0)" ::: "memory");
    __syncthreads();
    if (threadIdx.x == 0) {
        unsigned* bar = b.bar;
        unsigned bx_ = b.x; asm volatile("" : "+s"(bx_));
        __builtin_amdgcn_s_waitcnt(0);
        unsigned nloc = b.st[0], nx = b.st[1];
        if (nloc == 0u) { xcd_barrier_complete(bar, bx_, nloc, nx); b.st[0] = nloc; b.st[1] = nx; }
        const unsigned old = xb_add(&bar[XB_XSUB(bx_)], 1u);
        const unsigned gen = old / nloc;
        if (old + 1u == (gen + 1u) * nloc) {
            __builtin_amdgcn_fence(__ATOMIC_RELEASE, "agent");
            asm volatile("s_waitcnt vmcnt(0)" ::: "memory");
            asm volatile("buffer_inv sc1" ::: "memory");
            const unsigned og = xb_add(&bar[XB_TOP], 1u);
            const unsigned tg = og / nx;
            if (og + 1u == (tg + 1u) * nx) xb_add(&bar[XB_TOPGEN], 1u);
            else XB_SPIN(xb_ld(&bar[XB_TOPGEN]) == tg, bar);
            xb_add(&bar[XB_XGEN(bx_)], 1u);
            asm volatile("s_waitcnt vmcnt(0)" ::: "memory");
        } else {
            asm volatile("buffer_inv sc1" ::: "memory");
            XB_SPIN(xb_ld(&bar[XB_XGEN(bx_)]) == gen, bar);
            asm volatile("s_waitcnt vmcnt(0)" ::: "memory");
        }
    }
    __syncthreads();
}
typedef unsigned short bf16_t;
typedef short bf16x8 __attribute__((ext_vector_type(8)));
typedef float f32x4 __attribute__((ext_vector_type(4)));
typedef float f32x16 __attribute__((ext_vector_type(16)));
typedef unsigned u32x4 __attribute__((ext_vector_type(4)));
typedef unsigned u32x2 __attribute__((ext_vector_type(2)));

constexpr int DM = 1024, NB = 8, SEQ = 2048, DEPTH = 4, M = NB * SEQ, INW = 2560, FFH = 2816, GUW = 5632;
constexpr float RMS_EPS = 1e-6f, LN_EPS = 1e-5f;
constexpr size_t MiB = 1u << 20;
constexpr size_t WS_SS = 0;
constexpr size_t WS_SSB = 256 * MiB;
constexpr size_t WS_BAR = 1536 * 1024, BAR_BYTES = 16384;
constexpr size_t WS_WSG = 1 * MiB;
constexpr size_t WS_W = 2 * MiB;
constexpr size_t W_LAYER = 47 * MiB / 2;
constexpr size_t WOFF_IN = 0, WOFF_OUT = 5 * MiB, WOFF_GU = 7 * MiB, WOFF_DN = 18 * MiB;
constexpr size_t WS_XB = 96 * MiB, WS_Y = 128 * MiB, WS_PROJ = 160 * MiB, WS_VT = 240 * MiB, WS_H = 160 * MiB, WS_END = 257 * MiB;
constexpr int LDS_BYTES = 135168;

__device__ __forceinline__ unsigned cvtpk(float lo, float hi) { typedef float f2 __attribute__((ext_vector_type(2))); typedef __bf16 b2 __attribute__((ext_vector_type(2))); f2 v = {lo, hi}; b2 b = __builtin_convertvector(v, b2); return __builtin_bit_cast(unsigned, b); }
__device__ __forceinline__ bf16_t f2bf(float f) { return (bf16_t)(cvtpk(f, 0.f) & 0xffffu); }
__device__ __forceinline__ float bf2f(unsigned short b) { return __uint_as_float((unsigned)b << 16); }
__device__ __forceinline__ float bflo(unsigned w) { return __uint_as_float(w << 16); }
__device__ __forceinline__ float bfhi(unsigned w) { return __uint_as_float(w & 0xffff0000u); }
__device__ __forceinline__ u32x4 pack8(f32x4 a, f32x4 b) { u32x4 w; w.x = cvtpk(a[0], a[1]); w.y = cvtpk(a[2], a[3]); w.z = cvtpk(b[0], b[1]); w.w = cvtpk(b[2], b[3]); return w; }
__device__ __forceinline__ float dot4(f32x4 a) { return (a[0] * a[0] + a[1] * a[1]) + (a[2] * a[2] + a[3] * a[3]); }
__device__ __forceinline__ float sigmoidf_(float x) { return __builtin_amdgcn_rcpf(1.f + __builtin_amdgcn_exp2f(x * -1.44269504089f)); }
__device__ __forceinline__ float gelu_erf(float v) {
    const float av = fabsf(v), t = __builtin_amdgcn_rcpf(av * 0.2316418882f + 1.0f);
    float q = t * 0.5307027145f + (-0.7265760135f); q = q * t + 0.7107068705f; q = q * t + (-0.142248368f); q = q * t + 0.127414796f; q = q * t;
    const float e = __builtin_amdgcn_exp2f((v * v) * (-0.72134752044f));
    const float m = v * (q * e);
    return v < 0.f ? m : v - m;
}
__device__ __forceinline__ void wave_sum_n8(float (&v)[8]) {
#pragma unroll
    for (int o = 1; o < 64; o <<= 1) { float t[8];
#pragma unroll
        for (int i = 0; i < 8; ++i) t[i] = __shfl_xor(v[i], o);
#pragma unroll
        for (int i = 0; i < 8; ++i) v[i] += t[i]; }
}
__device__ __forceinline__ void wave_sum_n4(float (&v)[4]) {
#pragma unroll
    for (int o = 1; o < 64; o <<= 1) { float t[4];
#pragma unroll
        for (int i = 0; i < 4; ++i) t[i] = __shfl_xor(v[i], o);
#pragma unroll
        for (int i = 0; i < 4; ++i) v[i] += t[i]; }
}
__device__ __forceinline__ void wave_sum2(float& a, float& b) {
#pragma unroll
    for (int o = 1; o < 64; o <<= 1) { const float ta = __shfl_xor(a, o), tb = __shfl_xor(b, o); a += ta; b += tb; }
}
__device__ __forceinline__ float xsum16(float s) { const auto r = __builtin_amdgcn_permlane16_swap(__float_as_uint(s), __float_as_uint(s), false, false); return __uint_as_float(r[0]) + __uint_as_float(r[1]); }
__device__ __forceinline__ float xsum32(float s) { const auto r = __builtin_amdgcn_permlane32_swap(__float_as_uint(s), __float_as_uint(s), false, false); return __uint_as_float(r[0]) + __uint_as_float(r[1]); }
__device__ __forceinline__ float wave_sum(float v) {
#pragma unroll
    for (int o = 1; o < 64; o <<= 1) v += __shfl_xor(v, o);
    return v;
}
__device__ __forceinline__ float row_rinv(const float* SS, int row) { const f32x4* p = (const f32x4*)(SS + (size_t)row * 16); const f32x4 a = p[0], b = p[1], c = p[2], d = p[3];
    const float s = ((a[0] + a[1]) + (a[2] + a[3])) + ((b[0] + b[1]) + (b[2] + b[3])) + ((c[0] + c[1]) + (c[2] + c[3])) + ((d[0] + d[1]) + (d[2] + d[3])); return rsqrtf(s * (1.f / 1024.f) + RMS_EPS); }
__device__ __forceinline__ int crow(int r, int hi) { return (r & 3) + 8 * (r >> 2) + 4 * hi; }

__host__ __device__ __forceinline__ int inproj_ltile(int pn) { return (pn == 2 || pn == 3) ? pn + 6 : ((pn == 8 || pn == 9) ? pn - 6 : pn); }
struct EpiInProj {
    static constexpr bool PERM = true, AFTER_DRAIN = false;
    bf16_t* PROJ; bf16_t* VT; const float* SS; const float* qg; const float* kg;
    __device__ __forceinline__ void operator()(const pg8::f32x4 (&acc)[2][2][4][2], const pg8::Unit& u, int wr, int wc, int fr, int fq) const {
        const int pn = inproj_ltile(u.pn);
        const int colbase = pn * 256 + 64 * wc + 8 * fq;
        f32x4 gqk[2][2];
        { const float* g = pn < 6 ? qg : kg;
#pragma unroll
          for (int bj = 0; bj < 2; ++bj)
#pragma unroll
            for (int n = 0; n < 2; ++n) gqk[bj][n] = (pn >= 4 && pn < 8) ? *(const f32x4*)(g + 32 * bj + 8 * fq + 4 * n) : (f32x4){1.f, 1.f, 1.f, 1.f}; }
        float rinvs[2][4];
        { f32x4 pv[2][4];
#pragma unroll
          for (int ai = 0; ai < 2; ++ai)
#pragma unroll
            for (int m = 0; m < 4; ++m) pv[ai][m] = *(const f32x4*)(SS + (size_t)(u.pm * 256 + ai * 128 + wr * 64 + m * 16 + fr) * 16 + 4 * fq);
#pragma unroll
          for (int ai = 0; ai < 2; ++ai)
#pragma unroll
            for (int m = 0; m < 4; ++m) { float s = (pv[ai][m][0] + pv[ai][m][1]) + (pv[ai][m][2] + pv[ai][m][3]); s = xsum16(s); s = xsum32(s); rinvs[ai][m] = rsqrtf(s * (1.f / 1024.f) + RMS_EPS); } }
#pragma unroll
        for (int ai = 0; ai < 2; ++ai)
#pragma unroll
            for (int m = 0; m < 4; ++m) {
                const int row = u.pm * 256 + ai * 128 + wr * 64 + m * 16 + fr;
                const float rinv = rinvs[ai][m];
                f32x4 v[2][2];
#pragma unroll
                for (int bj = 0; bj < 2; ++bj)
#pragma unroll
                    for (int n = 0; n < 2; ++n) v[bj][n] = acc[ai][bj][m][n] * rinv;
                if (pn >= 4 && pn < 8) {
                    float ss = (dot4(v[0][0]) + dot4(v[0][1])) + (dot4(v[1][0]) + dot4(v[1][1]));
                    ss = xsum16(ss); ss = xsum32(ss);
                    const float hr = rsqrtf(ss * (1.f / 64.f) + RMS_EPS) * (pn < 6 ? 0.125f * 1.44269504089f : 1.f);
#pragma unroll
                    for (int bj = 0; bj < 2; ++bj)
#pragma unroll
                        for (int n = 0; n < 2; ++n) v[bj][n] = v[bj][n] * gqk[bj][n] * hr;
                }
                if (pn < 8) {
#pragma unroll
                    for (int bj = 0; bj < 2; ++bj) *(u32x4*)(PROJ + (size_t)row * INW + colbase + 32 * bj) = pack8(v[bj][0], v[bj][1]);
                } else {
                    const int hd0 = ((pn - 8) * 4 + wc) * 64 + 8 * fq;
#pragma unroll
                    for (int bj = 0; bj < 2; ++bj)
#pragma unroll
                        for (int n = 0; n < 2; ++n)
#pragma unroll
                            for (int j = 0; j < 4; ++j) VT[(size_t)(hd0 + 32 * bj + 4 * n + j) * M + row] = f2bf(v[bj][n][j]);
                }
            }
    }
};
struct EpiRes {
    static constexpr bool PERM = true, AFTER_DRAIN = false;
    const float* base32; float* out32; bf16_t* XB; float* SSn;
    __device__ __forceinline__ void operator()(const pg8::f32x4 (&acc)[2][2][4][2], const pg8::Unit& u, int wr, int wc, int fr, int fq) const {
        const int col0 = u.pn * 256 + 32 * wc + 8 * fq;
#pragma unroll
        for (int ai = 0; ai < 2; ++ai)
#pragma unroll
            for (int mh = 0; mh < 2; ++mh) {
                const size_t off0 = (size_t)(u.pm * 256 + ai * 128 + wr * 64 + mh * 32 + fr) * DM + col0;
                f32x4 b0[2][2], b1[2][2];
                if (base32) {
#pragma unroll
                    for (int mm = 0; mm < 2; ++mm)
#pragma unroll
                        for (int bj = 0; bj < 2; ++bj) { const float* p = base32 + off0 + (size_t)mm * 16 * DM + 128 * bj;
                            b0[mm][bj] = __builtin_nontemporal_load((const f32x4*)p); b1[mm][bj] = __builtin_nontemporal_load((const f32x4*)(p + 4)); }
                } else {
                    u32x4 w[2][2];
#pragma unroll
                    for (int mm = 0; mm < 2; ++mm)
#pragma unroll
                        for (int bj = 0; bj < 2; ++bj) w[mm][bj] = *(const u32x4*)(XB + off0 + (size_t)mm * 16 * DM + 128 * bj);
#pragma unroll
                    for (int mm = 0; mm < 2; ++mm)
#pragma unroll
                        for (int bj = 0; bj < 2; ++bj) { const u32x4 x = w[mm][bj]; b0[mm][bj] = (f32x4){bflo(x.x), bfhi(x.x), bflo(x.y), bfhi(x.y)}; b1[mm][bj] = (f32x4){bflo(x.z), bfhi(x.z), bflo(x.w), bfhi(x.w)}; }
                }
#pragma unroll
                for (int mm = 0; mm < 2; ++mm) {
                    const int m = 2 * mh + mm;
                    const int row = u.pm * 256 + ai * 128 + wr * 64 + m * 16 + fr;
                    float ss = 0.f;
#pragma unroll
                    for (int bj = 0; bj < 2; ++bj) {
                        const size_t off = off0 + (size_t)mm * 16 * DM + 128 * bj;
                        const f32x4 v0 = b0[mm][bj] + acc[ai][bj][m][0], v1 = b1[mm][bj] + acc[ai][bj][m][1];
                        if (out32) { __builtin_nontemporal_store(v0, (f32x4*)(out32 + off)); __builtin_nontemporal_store(v1, (f32x4*)(out32 + off + 4)); }
                        else { *(u32x4*)(XB + off) = pack8(v0, v1); ss += dot4(v0) + dot4(v1); }
                    }
                    if (!out32) { ss = xsum16(ss); ss = xsum32(ss); if (fq == 0) SSn[(size_t)row * 16 + u.pn * 4 + wc] = ss; }
                }
            }
    }
};
struct EpiSwiglu {
    static constexpr bool PERM = true, AFTER_DRAIN = false;
    bf16_t* H; const float* SS;
    __device__ __forceinline__ void operator()(const pg8::f32x4 (&acc)[2][2][4][2], const pg8::Unit& u, int wr, int wc, int fr, int fq) const {
        const int col0 = u.pn * 128 + 32 * wc + 8 * fq;
        const __amdgpu_buffer_rsrc_t hrs = __builtin_amdgcn_make_buffer_rsrc(H, 0, M * FFH * 2, 0x00020000);
        float rinvs[2][4];
        { f32x4 pv[2][4];
#pragma unroll
          for (int ai = 0; ai < 2; ++ai)
#pragma unroll
            for (int m = 0; m < 4; ++m) pv[ai][m] = *(const f32x4*)(SS + (size_t)(u.pm * 256 + ai * 128 + wr * 64 + m * 16 + fr) * 16 + 4 * fq);
#pragma unroll
          for (int ai = 0; ai < 2; ++ai)
#pragma unroll
            for (int m = 0; m < 4; ++m) { float s = (pv[ai][m][0] + pv[ai][m][1]) + (pv[ai][m][2] + pv[ai][m][3]); s = xsum16(s); s = xsum32(s); rinvs[ai][m] = rsqrtf(s * (1.f / 1024.f) + RMS_EPS); } }
#pragma unroll
        for (int ai = 0; ai < 2; ++ai)
#pragma unroll
            for (int m = 0; m < 4; ++m) {
                const int row = u.pm * 256 + ai * 128 + wr * 64 + m * 16 + fr;
                const float rinv = rinvs[ai][m];
                f32x4 h[2];
#pragma unroll
                for (int n = 0; n < 2; ++n) {
                    const f32x4 g = acc[ai][0][m][n] * rinv, up = acc[ai][1][m][n] * rinv;
#pragma unroll
                    for (int j = 0; j < 4; ++j) h[n][j] = g[j] * sigmoidf_(g[j]) * up[j];
                }
                __builtin_amdgcn_raw_buffer_store_b128(pack8(h[0], h[1]), hrs, (unsigned)(((size_t)row * FFH + col0) * 2), 0,   16);
            }
    }
};

__device__ __forceinline__ void transpose_item(const float* W, int K, int N, bf16_t* WT, const float* gain, LAS float* scr, int kb, int n0, int src0, int lane) {
    const int k0 = 64 * kb;
    const float* src = W + (size_t)(k0 + (lane >> 5)) * N + src0 + (lane & 31);
    float w[32];
#pragma unroll
    for (int i = 0; i < 32; ++i) w[i] = __builtin_nontemporal_load(src + (size_t)(2 * i) * N);
    const int c = lane & 7;
    f32x4 g0 = {1.f, 1.f, 1.f, 1.f}, g1 = {1.f, 1.f, 1.f, 1.f};
    if (gain) { g0 = *(const f32x4*)(gain + k0 + 8 * c); g1 = *(const f32x4*)(gain + k0 + 8 * c + 4); }
#pragma unroll
    for (int i = 0; i < 32; ++i) scr[(2 * i + (lane >> 5)) * 33 + (lane & 31)] = w[i];
    asm volatile("s_waitcnt lgkmcnt(0)" ::: "memory");
#pragma unroll
    for (int j = 0; j < 4; ++j) { const int n = (lane >> 3) + 8 * j; const LAS float* s = scr + (8 * c) * 33 + n;
        u32x4 o; o.x = cvtpk(s[0 * 33] * g0[0], s[1 * 33] * g0[1]); o.y = cvtpk(s[2 * 33] * g0[2], s[3 * 33] * g0[3]); o.z = cvtpk(s[4 * 33] * g1[0], s[5 * 33] * g1[1]); o.w = cvtpk(s[6 * 33] * g1[2], s[7 * 33] * g1[3]);
        *(u32x4*)(WT + (size_t)(n0 + n) * K + k0 + 8 * c) = o; }
    asm volatile("s_waitcnt lgkmcnt(0)" ::: "memory");
}

__device__ __forceinline__ void sb_tile(const bf16x8 (&kf)[4], const bf16x8 (&qf)[4], const bf16x8 (&vf)[2][2], bool diag, int q, int hi, float& carry, f32x16& o0, f32x16& o1) {
    f32x16 z;
#pragma unroll
    for (int r = 0; r < 16; ++r) z[r] = 0.f;
#pragma unroll
    for (int kb = 0; kb < 4; ++kb) z = __builtin_amdgcn_mfma_f32_32x32x16_bf16(kf[kb], qf[kb], z, 0, 0, 0);
    float be[16], nb[16];
#pragma unroll
    for (int r = 0; r < 16; ++r) {
        const float zr = z[r];
        const float e = __builtin_amdgcn_exp2f(-fabsf(zr)), rr = __builtin_amdgcn_rcpf(1.f + e), er = e * rr;
        const bool msk = diag && (16 * (r >> 3) + 8 * hi + (r & 7)) >= q;
        be[r] = msk ? 0.f : (zr >= 0.f ? rr : er);
        nb[r] = msk ? 1.f : (zr >= 0.f ? er : rr);
    }
    float att[16];
#pragma unroll
    for (int g = 0; g < 2; ++g) {
        float p = 1.f;
#pragma unroll
        for (int i = 7; i >= 0; --i) { att[8 * g + i] = be[8 * g + i] * p; p *= nb[8 * g + i]; }
        nb[8 * g] = p;
    }
    const float T0 = nb[0], T1 = nb[8], P0 = __shfl_xor(T0, 32), P1 = __shfl_xor(T1, 32);
    const float run1 = T1 * P1;
    const float e1 = carry * (hi == 0 ? P1 : 1.f), e0 = carry * run1 * (hi == 0 ? P0 : 1.f);
#pragma unroll
    for (int r = 0; r < 16; ++r) att[r] *= (r < 8 ? e0 : e1);
    carry *= run1 * (T0 * P0);
    u32x4 pa0, pa1;
    pa0.x = cvtpk(att[0], att[1]); pa0.y = cvtpk(att[2], att[3]); pa0.z = cvtpk(att[4], att[5]); pa0.w = cvtpk(att[6], att[7]);
    pa1.x = cvtpk(att[8], att[9]); pa1.y = cvtpk(att[10], att[11]); pa1.z = cvtpk(att[12], att[13]); pa1.w = cvtpk(att[14], att[15]);
    o0 = __builtin_amdgcn_mfma_f32_32x32x16_bf16(vf[0][0], __builtin_bit_cast(bf16x8, pa0), o0, 0, 0, 0);
    o0 = __builtin_amdgcn_mfma_f32_32x32x16_bf16(vf[0][1], __builtin_bit_cast(bf16x8, pa1), o0, 0, 0, 0);
    o1 = __builtin_amdgcn_mfma_f32_32x32x16_bf16(vf[1][0], __builtin_bit_cast(bf16x8, pa0), o1, 0, 0, 0);
    o1 = __builtin_amdgcn_mfma_f32_32x32x16_bf16(vf[1][1], __builtin_bit_cast(bf16x8, pa1), o1, 0, 0, 0);
}
__device__ __forceinline__ void sb_stage(LAS unsigned char* wt, int r, int hi, const f32x16& o0, const f32x16& o1, float rinv) {
#pragma unroll
    for (int a = 0; a < 4; ++a) {
        u32x2 w0; w0.x = cvtpk(o0[4 * a] * rinv, o0[4 * a + 1] * rinv); w0.y = cvtpk(o0[4 * a + 2] * rinv, o0[4 * a + 3] * rinv);
        *(LAS u32x2*)(wt + r * 128 + ((a ^ (r & 7)) * 16) + 8 * hi) = w0;
        u32x2 w1; w1.x = cvtpk(o1[4 * a] * rinv, o1[4 * a + 1] * rinv); w1.y = cvtpk(o1[4 * a + 2] * rinv, o1[4 * a + 3] * rinv);
        *(LAS u32x2*)(wt + r * 128 + (((4 + a) ^ (r & 7)) * 16) + 8 * hi) = w1;
    }
}
__device__ __forceinline__ void attn_unit(const bf16_t* PROJ, const bf16_t* VT, bf16_t* Y, const float* outg, int b, int qb, LAS float* red, int wid, int lane) {
    const int h = wid, q = lane & 31, hi = lane >> 5;
    const int kperm = (q & 19) | ((q & 4) << 1) | ((q & 8) >> 1);
    const size_t rowA = (size_t)b * SEQ + 64 * qb + q;
    bf16x8 qfA[4], qfB[4];
#pragma unroll
    for (int kb = 0; kb < 4; ++kb) { qfA[kb] = *(const bf16x8*)(PROJ + rowA * INW + 1024 + h * 64 + 16 * kb + 8 * hi); qfB[kb] = *(const bf16x8*)(PROJ + (rowA + 32) * INW + 1024 + h * 64 + 16 * kb + 8 * hi); }
    f32x16 oA0, oA1, oB0, oB1;
#pragma unroll
    for (int r = 0; r < 16; ++r) { oA0[r] = 0.f; oA1[r] = 0.f; oB0[r] = 0.f; oB1[r] = 0.f; }
    float carryA = 1.f, carryB = 1.f;
    const bf16_t* Kbase = PROJ + ((size_t)b * SEQ + kperm) * INW + 1536 + h * 64 + 8 * hi;
    const bf16_t* Vbase = VT + (size_t)(h * 64 + q) * M + (size_t)b * SEQ + 8 * hi;
    bf16x8 kf[4], kn[4], vf[2][2];
#define LOADK(KF, kt_) do { _Pragma("unroll") for (int kb = 0; kb < 4; ++kb) KF[kb] = *(const bf16x8*)(Kbase + (size_t)(32 * (kt_)) * INW + 16 * kb); } while (0)
#define LOADV(VF, kt_) do { _Pragma("unroll") for (int d0 = 0; d0 < 2; ++d0) _Pragma("unroll") for (int k2 = 0; k2 < 2; ++k2) VF[d0][k2] = *(const bf16x8*)(Vbase + (size_t)(32 * d0) * M + 32 * (kt_) + 16 * k2); } while (0)
    const int ktop = 2 * qb + 1;
    LOADK(kf, ktop);
    for (int kt = ktop; kt >= 0; --kt) {
        LOADV(vf, kt);
        if (kt > 0) LOADK(kn, kt - 1);
        if (!__all(carryB == 0.f)) sb_tile(kf, qfB, vf, kt == ktop, q, hi, carryB, oB0, oB1);
        if (kt < ktop && !__all(carryA == 0.f)) sb_tile(kf, qfA, vf, kt == ktop - 1, q, hi, carryA, oA0, oA1);
        if (__all(carryA == 0.f && carryB == 0.f)) break;
#pragma unroll
        for (int kb = 0; kb < 4; ++kb) kf[kb] = kn[kb];
    }
#undef LOADK
#undef LOADV
    float ssA = 0.f, ssB = 0.f;
#pragma unroll
    for (int r = 0; r < 16; ++r) { ssA += oA0[r] * oA0[r] + oA1[r] * oA1[r]; ssB += oB0[r] * oB0[r] + oB1[r] * oB1[r]; }
    ssA += __shfl_xor(ssA, 32); ssB += __shfl_xor(ssB, 32);
    if (hi == 0) { red[wid * 64 + q] = ssA; red[wid * 64 + 32 + q] = ssB; }
    __syncthreads();
    float totA = 0.f, totB = 0.f;
#pragma unroll
    for (int w = 0; w < 8; ++w) { totA += red[w * 64 + q]; totB += red[w * 64 + 32 + q]; }
    bf16_t* yp = Y + rowA * DM + 512 + h * 64 + 4 * hi;
    LAS unsigned char* wt = (LAS unsigned char*)red + 2048 + wid * 8192;
    sb_stage(wt, q, hi, oA0, oA1, rsqrtf(totA * (1.f / 512.f) + RMS_EPS));
    sb_stage(wt, 32 + q, hi, oB0, oB1, rsqrtf(totB * (1.f / 512.f) + RMS_EPS));
    { const int rr = lane >> 3, cc = lane & 7;
      bf16_t* yrow = Y + ((size_t)b * SEQ + 64 * qb + rr) * DM + 512 + h * 64 + cc * 8;
#pragma unroll
      for (int j = 0; j < 8; ++j) { const int r = rr + 8 * j; const u32x4 v = *(const LAS u32x4*)(wt + r * 128 + ((cc ^ (r & 7)) * 16)); *(u32x4*)(yrow + (size_t)(8 * j) * DM) = v; } }
    __syncthreads();
}

__device__ __forceinline__ void conv_unit(const bf16_t* PROJ, bf16_t* Y, const float* cw, const float* cb, const float* lg, const float* lb, const float* outg,
                                          int b, int ti, LAS float* hbuf, LAS float* cbuf, int wid, int lane) {
    const int tid = wid * 64 + lane, t0 = 32 * ti;
    float w[31];
#pragma unroll
    for (int j = 0; j < 31; ++j) w[j] = cw[j * 256 + (tid & 255)];
    const float bias = cb[tid & 255];
    {
        u32x4 va[4], ga[4];
#pragma unroll
        for (int k = 0; k < 4; ++k) { const int it = tid + 512 * k, rr = it >> 5, c8 = (it & 31) * 8, t = t0 - 30 + rr;
            if (it < 62 * 32 && t >= 0) { const bf16_t* p = PROJ + ((size_t)b * SEQ + t) * INW + c8; va[k] = *(const u32x4*)p; ga[k] = *(const u32x4*)(p + 256); }
            else { va[k] = (u32x4){0u, 0u, 0u, 0u}; ga[k] = (u32x4){0u, 0u, 0u, 0u}; } }
#pragma unroll
        for (int k = 0; k < 4; ++k) { const int it = tid + 512 * k, rr = it >> 5, c8 = (it & 31) * 8;
            if (it < 62 * 32) {
                f32x4 h0, h1;
                h0[0] = bflo(va[k].x) * sigmoidf_(bflo(ga[k].x)); h0[1] = bfhi(va[k].x) * sigmoidf_(bfhi(ga[k].x));
                h0[2] = bflo(va[k].y) * sigmoidf_(bflo(ga[k].y)); h0[3] = bfhi(va[k].y) * sigmoidf_(bfhi(ga[k].y));
                h1[0] = bflo(va[k].z) * sigmoidf_(bflo(ga[k].z)); h1[1] = bfhi(va[k].z) * sigmoidf_(bfhi(ga[k].z));
                h1[2] = bflo(va[k].w) * sigmoidf_(bflo(ga[k].w)); h1[3] = bfhi(va[k].w) * sigmoidf_(bfhi(ga[k].w));
                *(LAS f32x4*)(hbuf + rr * 256 + c8) = h0; *(LAS f32x4*)(hbuf + rr * 256 + c8 + 4) = h1;
            } }
    }
    __syncthreads();
    {
        const int c = tid & 255, half = tid >> 8;
        float acc[16];
#pragma unroll
        for (int tt = 0; tt < 16; ++tt) acc[tt] = bias;
#pragma unroll
        for (int i = 0; i < 46; ++i) {
            const float v = hbuf[(half * 16 + i) * 256 + c];
#pragma unroll
            for (int tt = 0; tt < 16; ++tt) { const int j = i - tt; if (j >= 0 && j <= 30) acc[tt] += w[j] * v; }
        }
#pragma unroll
        for (int tt = 0; tt < 16; ++tt) cbuf[(half * 16 + tt) * 256 + c] = acc[tt];
    }
    __syncthreads();
    {
        const f32x4 gv = *(const f32x4*)(lg + 4 * lane), bv = *(const f32x4*)(lb + 4 * lane);
        f32x4 x[4]; float sv[8];
#pragma unroll
        for (int k = 0; k < 4; ++k) { x[k] = *(LAS f32x4*)(cbuf + (wid + 8 * k) * 256 + 4 * lane);
            sv[2 * k] = (x[k][0] + x[k][1]) + (x[k][2] + x[k][3]); sv[2 * k + 1] = dot4(x[k]); }
        wave_sum_n8(sv);
        f32x4 sl[4]; float rs[4];
#pragma unroll
        for (int k = 0; k < 4; ++k) {
            const float mean = sv[2 * k] * (1.f / 256.f);
            const float rstd = rsqrtf(fmaxf(sv[2 * k + 1] * (1.f / 256.f) - mean * mean, 0.f) + LN_EPS);
#pragma unroll
            for (int j = 0; j < 4; ++j) { const float y = (x[k][j] - mean) * rstd * gv[j] + bv[j]; sl[k][j] = y * sigmoidf_(y); }
            rs[k] = dot4(sl[k]);
        }
        wave_sum_n4(rs);
#pragma unroll
        for (int k = 0; k < 4; ++k) {
            const float rinv = rsqrtf(rs[k] * (1.f / 256.f) + RMS_EPS);
            u32x2 o; o.x = cvtpk(sl[k][0] * rinv, sl[k][1] * rinv); o.y = cvtpk(sl[k][2] * rinv, sl[k][3] * rinv);
            *(u32x2*)(Y + ((size_t)b * SEQ + t0 + wid + 8 * k) * DM + 4 * lane) = o;
        }
    }
    __syncthreads();
}

constexpr int VT_P = 136;
__device__ __forceinline__ void sg_unit(const bf16_t* PROJ, bf16_t* Y, const bf16_t* WSG, const float* sgb, const float* lg, const float* lb, const float* outg,
                                        int b, int n, int th, LAS bf16_t* vT, LAS float* red, int wid, int lane) {
    const int smax = 64 * (th + 1);
    const size_t row0 = (size_t)b * SEQ + 128 * n;
    {
        const f32x4 gv = *(const f32x4*)(lg + 4 * lane), bv = *(const f32x4*)(lb + 4 * lane);
        const int ntrip = smax >> 5;
        u32x2 raw[4][4];
#pragma unroll
        for (int i = 0; i < 4; ++i) if (i < ntrip) {
#pragma unroll
            for (int k = 0; k < 4; ++k) raw[i][k] = *(const u32x2*)(PROJ + (row0 + 32 * i + 4 * wid + k) * INW + 768 + 4 * lane); }
#pragma unroll
        for (int i = 0; i < 4; ++i) if (i < ntrip) {
            f32x4 x[4]; float sv[8];
#pragma unroll
            for (int k = 0; k < 4; ++k) { x[k] = (f32x4){gelu_erf(bflo(raw[i][k].x)), gelu_erf(bfhi(raw[i][k].x)), gelu_erf(bflo(raw[i][k].y)), gelu_erf(bfhi(raw[i][k].y))};
                sv[2 * k] = (x[k][0] + x[k][1]) + (x[k][2] + x[k][3]); sv[2 * k + 1] = dot4(x[k]); }
            wave_sum_n8(sv);
#pragma unroll
            for (int k = 0; k < 4; ++k) {
                const float mean = sv[2 * k] * (1.f / 256.f);
                const float rstd = rsqrtf(fmaxf(sv[2 * k + 1] * (1.f / 256.f) - mean * mean, 0.f) + LN_EPS);
#pragma unroll
                for (int j = 0; j < 4; ++j) x[k][j] = (x[k][j] - mean) * rstd * gv[j] + bv[j];
            }
#pragma unroll
            for (int j = 0; j < 4; ++j) { u32x2 w; w.x = cvtpk(x[0][j], x[1][j]); w.y = cvtpk(x[2][j], x[3][j]);
                *(LAS u32x2*)(vT + (4 * lane + j) * VT_P + 32 * i + 4 * wid) = w; }
        }
    }
    __syncthreads();
    const int nt2 = wid & 1, cq = wid >> 1, t31 = lane & 31, hi = lane >> 5;
    const int tl = 64 * th + 32 * nt2 + t31;
    f32x16 acc0, acc1;
#pragma unroll
    for (int r = 0; r < 16; ++r) { acc0[r] = 0.f; acc1[r] = 0.f; }
    const int nkb = 2 * (2 * th + nt2 + 1);
    const bf16_t* wrow = WSG + ((size_t)cq * 128 + tl) * 128 + 8 * hi;
    const LAS bf16_t* a0 = vT + (64 * cq + t31) * VT_P + 8 * hi;
    bf16x8 Bf[8];
#pragma unroll
    for (int kb = 0; kb < 8; ++kb) if (kb < nkb) Bf[kb] = *(const bf16x8*)(wrow + 16 * kb);
    const bf16_t* up = PROJ + (row0 + tl) * INW + 512 + 64 * cq + 4 * hi;
    u32x2 ur0[4], ur1[4];
#pragma unroll
    for (int a = 0; a < 4; ++a) { ur0[a] = *(const u32x2*)(up + 8 * a); ur1[a] = *(const u32x2*)(up + 32 + 8 * a); }
    const float bias = sgb[cq * 128 + tl];
#pragma unroll
    for (int kb = 0; kb < 8; ++kb) if (kb < nkb) {
        const bf16x8 A0 = *(const LAS bf16x8*)(a0 + 16 * kb), A1 = *(const LAS bf16x8*)(a0 + 32 * VT_P + 16 * kb);
        acc0 = __builtin_amdgcn_mfma_f32_32x32x16_bf16(A0, Bf[kb], acc0, 0, 0, 0);
        acc1 = __builtin_amdgcn_mfma_f32_32x32x16_bf16(A1, Bf[kb], acc1, 0, 0, 0);
    }
    float ss = 0.f;
#pragma unroll
    for (int a = 0; a < 4; ++a) {
        const u32x2 r0 = ur0[a], r1 = ur1[a];
        acc0[4 * a + 0] = gelu_erf(bflo(r0.x)) * (acc0[4 * a + 0] + bias); acc0[4 * a + 1] = gelu_erf(bfhi(r0.x)) * (acc0[4 * a + 1] + bias);
        acc0[4 * a + 2] = gelu_erf(bflo(r0.y)) * (acc0[4 * a + 2] + bias); acc0[4 * a + 3] = gelu_erf(bfhi(r0.y)) * (acc0[4 * a + 3] + bias);
        acc1[4 * a + 0] = gelu_erf(bflo(r1.x)) * (acc1[4 * a + 0] + bias); acc1[4 * a + 1] = gelu_erf(bfhi(r1.x)) * (acc1[4 * a + 1] + bias);
        acc1[4 * a + 2] = gelu_erf(bflo(r1.y)) * (acc1[4 * a + 2] + bias); acc1[4 * a + 3] = gelu_erf(bfhi(r1.y)) * (acc1[4 * a + 3] + bias);
    }
#pragma unroll
    for (int r = 0; r < 16; ++r) ss += acc0[r] * acc0[r] + acc1[r] * acc1[r];
    ss += __shfl_xor(ss, 32);
    if (hi == 0) red[cq * 64 + 32 * nt2 + t31] = ss;
    __syncthreads();
    const int tloc = 32 * nt2 + t31;
    const float rinv = rsqrtf(((red[tloc] + red[64 + tloc]) + (red[128 + tloc] + red[192 + tloc])) * (1.f / 256.f) + RMS_EPS);
    bf16_t* yp = Y + (row0 + tl) * DM + 256 + 64 * cq + 4 * hi;
#pragma unroll
    for (int a = 0; a < 4; ++a) {
        u32x2 o; o.x = cvtpk(acc0[4 * a] * rinv, acc0[4 * a + 1] * rinv); o.y = cvtpk(acc0[4 * a + 2] * rinv, acc0[4 * a + 3] * rinv);
        *(u32x2*)(yp + 8 * a) = o;
        u32x2 p; p.x = cvtpk(acc1[4 * a] * rinv, acc1[4 * a + 1] * rinv); p.y = cvtpk(acc1[4 * a + 2] * rinv, acc1[4 * a + 3] * rinv);
        *(u32x2*)(yp + 32 + 8 * a) = p;
    }
    __syncthreads();
}

#ifdef PROBE_BARX2
#define GSYNC() do { xcd_barrier(bar); xcd_barrier(bar); } while (0)
#else
#define GSYNC() xcd_barrier(bar)
#endif
struct Args { const float* in[18]; float* out; unsigned char* ws; };
__device__ __forceinline__ void convert_item(const Args& a, unsigned char* ws, int l, int r, LAS float* scr, int lane) {
    bf16_t* wl = (bf16_t*)(ws + WS_W + (size_t)l * W_LAYER);
    if (r < 1280) { const int kb = r / 80, nb = r - kb * 80, n0 = 32 * nb, pn = n0 >> 8, p = n0 & 255, bj = p >> 7, wc = (p >> 5) & 3;
        transpose_item(a.in[2] + (size_t)l * DM * INW, DM, INW, wl + WOFF_IN / 2, a.in[1] + l * DM, scr, kb, n0, 256 * inproj_ltile(pn) + 64 * wc + 32 * bj, lane); }
    else if (r < 1792) { r -= 1280; const int kb = r >> 5, nb = r & 31;
        transpose_item(a.in[14] + (size_t)l * DM * DM, DM, DM, wl + WOFF_OUT / 2, a.in[13] + l * DM, scr, kb, 32 * nb, 32 * nb, lane); }
    else if (r < 4608) { r -= 1792; const int kb = r / 176, nb = r - kb * 176, n0 = 32 * nb, pn = n0 >> 8, p = n0 & 255, bj = p >> 7, q = (p >> 5) & 3;
        transpose_item(a.in[16] + (size_t)l * DM * GUW, DM, GUW, wl + WOFF_GU / 2, a.in[15] + l * DM, scr, kb, n0, (bj ? FFH : 0) + 128 * pn + 32 * q, lane); }
    else { r -= 4608; const int kb = r >> 5, nb = r & 31;
        transpose_item(a.in[17] + (size_t)l * FFH * DM, FFH, DM, wl + WOFF_DN / 2, nullptr, scr, kb, 32 * nb, 32 * nb, lane); }
}
__global__ void __launch_bounds__(512, 2) mega_fwd(Args a) {
    extern __shared__ __attribute__((aligned(16))) unsigned char lds_raw[];
    LAS unsigned char* lds = (LAS unsigned char*)lds_raw;
    const int tid = threadIdx.x, lane = tid & 63, wid = __builtin_amdgcn_readfirstlane(tid >> 6);
    const int G = gridDim.x, bx = blockIdx.x, gw = bx * 8 + wid, NGW = G * 8;
    unsigned char* ws = a.ws;
    const float* x_in = a.in[0];
    float* SSA = (float*)(ws + WS_SS); float* SSB = (float*)(ws + WS_SSB);
    bf16_t* WSG = (bf16_t*)(ws + WS_WSG);
    bf16_t* XB = (bf16_t*)(ws + WS_XB); bf16_t* Yb = (bf16_t*)(ws + WS_Y); bf16_t* PROJ = (bf16_t*)(ws + WS_PROJ); bf16_t* VT = (bf16_t*)(ws + WS_VT); bf16_t* Hb = (bf16_t*)(ws + WS_H);
    float* out = a.out;
    volatile LAS unsigned* bst = (volatile LAS unsigned*)(lds + LDS_BYTES - 16);
    if (tid < 4) bst[tid] = 0u;
    __syncthreads();
    XcdBarrier bar = xcd_barrier_post((unsigned*)(ws + WS_BAR), bst);
    if (a.ws == nullptr) cg::this_grid().sync();

#ifdef PROBE_P0X2
    for (int rep_ = 0; rep_ < 2; ++rep_)
#endif
    {
        LAS float* scr = (LAS float*)(lds + wid * 8448);
        for (int it = gw; it < 6016; it += NGW) convert_item(a, ws, 0, it, scr, lane);
        for (int m = gw; m < M; m += NGW) {
            const f32x4* xr = (const f32x4*)(x_in + (size_t)m * DM) + lane; float s = 0.f;
            u32x2* o = (u32x2*)(XB + (size_t)m * DM) + lane;
#pragma unroll
            for (int j = 0; j < 4; ++j) { const f32x4 v = __builtin_nontemporal_load(xr + 64 * j); s += dot4(v); u32x2 w; w.x = cvtpk(v[0], v[1]); w.y = cvtpk(v[2], v[3]); o[64 * j] = w; }
            s = wave_sum(s); if (lane < 16) SSB[(size_t)m * 16 + lane] = lane == 0 ? s : 0.f;
        }
        for (int i = bx * 512 + tid; i < DEPTH * 4 * 128 * 128; i += G * 512) { const int s = i & 127, t = (i >> 7) & 127; WSG[i] = f2bf(s <= t ? a.in[9][i] : 0.f); }
    }
    GSYNC();

#define SPARE_CONVERT(lo, hi) do { if (l + 1 < DEPTH) { const bool half_ = (G == 256); if (!half_ || bx >= 128) { const int nw_ = (half_ ? 128 : G) * 8, w0_ = ((half_ ? bx - 128 : bx) * 8 + wid); \
        int lane_c = threadIdx.x & 63; asm volatile("" : "+v"(lane_c)); LAS float* scr_ = (LAS float*)(lds + wid * 8448); \
        for (int it = (lo) + w0_; it < (hi); it += nw_) convert_item(a, ws, l + 1, it, scr_, lane_c); } } } while (0)
    for (int l = 0; l < DEPTH; ++l) {
        const bf16_t* wl = (const bf16_t*)(ws + WS_W + (size_t)l * W_LAYER);
#ifdef PROBE_P1X2
        for (int rep_ = 0; rep_ < 2; ++rep_)
#endif
        { pg8::Gemm g{XB, wl + WOFF_IN / 2, M, INW, DM}; pg8::StaticOrder S; S.init(M, INW, G, bx);
          EpiInProj E{PROJ, VT, SSB, a.in[11] + l * 64, a.in[12] + l * 64};
          pg8::gemm_phase<EpiInProj, pg8::StaticOrder, true, true>(lds, g, S, E); }
        SPARE_CONVERT(0, 3008);
        GSYNC();
#ifdef PROBE_P2X2
        for (int rep_ = 0; rep_ < 2; ++rep_)
#endif
        {
            const float* outg = a.in[13] + l * DM;
            int lane_l = threadIdx.x & 63; asm volatile("" : "+v"(lane_l)); const int lane = lane_l;
#ifdef DIAG_FILL
            for (size_t i = (size_t)bx * 512 + threadIdx.x; i < (size_t)M * DM / 8; i += (size_t)G * 512) { const size_t r = i >> 7, c = (i & 127) * 8; *(u32x4*)(Yb + r * DM + c) = *(const u32x4*)(PROJ + r * INW + c); }
            GSYNC();
#endif
#ifndef DIAG_NOATTN
#ifdef PROBE_ATTNX2
            for (int rep2_ = 0; rep2_ < 2; ++rep2_)
#endif
            for (int p = bx; p < 256; p += G) {
                const int b = p & 7, s = p >> 3;
                attn_unit(PROJ, VT, Yb, outg + 512, b, s, (LAS float*)lds, wid, lane);
            }
#endif
#ifndef DIAG_NOCONV
#ifdef PROBE_CONVX2
            for (int rep2_ = 0; rep2_ < 2; ++rep2_)
#endif
            for (int id = bx; id < 512; id += G)
                conv_unit(PROJ, Yb, a.in[3] + l * 31 * 256, a.in[4] + l * 256, a.in[5] + l * 256, a.in[6] + l * 256, outg, id & 7, (id >> 3) & 63, (LAS float*)lds, (LAS float*)(lds + 63488), wid, lane);
#endif
#ifndef DIAG_NOSG
#ifdef PROBE_SGX2
            for (int rep2_ = 0; rep2_ < 2; ++rep2_)
#endif
            for (int id = bx; id < 256; id += G)
                sg_unit(PROJ, Yb, WSG + (size_t)l * 4 * 128 * 128, a.in[10] + l * 512, a.in[7] + l * 256, a.in[8] + l * 256, outg + 256, id & 7, (id >> 4) & 15, (id >> 3) & 1,
                        (LAS bf16_t*)lds, (LAS float*)(lds + 69632), wid, lane);
#endif
        }
        GSYNC();
        { pg8::Gemm g{Yb, wl + WOFF_OUT / 2, M, DM, DM}; pg8::StaticOrder S; S.init(M, DM, G, bx);
          EpiRes E{l == 0 ? x_in : nullptr, nullptr, XB, SSA};
          pg8::gemm_phase<EpiRes, pg8::StaticOrder, true, true>(lds, g, S, E); }
        GSYNC();
#ifdef PROBE_P4X2
        for (int rep_ = 0; rep_ < 2; ++rep_)
#endif
        { pg8::Gemm g{XB, wl + WOFF_GU / 2, M, GUW, DM}; pg8::StaticOrder S; S.init(M, GUW, G, bx);
          EpiSwiglu E{Hb, SSA};
          pg8::gemm_phase<EpiSwiglu, pg8::StaticOrder, true, true>(lds, g, S, E); }
        SPARE_CONVERT(3008, 6016);
        GSYNC();
        { pg8::Gemm g{Hb, wl + WOFF_DN / 2, M, DM, FFH}; pg8::StaticOrder S; S.init(M, DM, G, bx);
          const bool last = (l == DEPTH - 1);
          EpiRes E{nullptr, last ? out : nullptr, XB, SSB};
          pg8::gemm_phase<EpiRes, pg8::StaticOrder, true, true>(lds, g, S, E); }
        if (l + 1 < DEPTH) GSYNC();
    }
}

extern "C" void kernel_launch(void* const* d_in, const int* in_sizes, int n_in, void* d_out, int out_size, void* d_ws, size_t ws_size, hipStream_t stream) {
    static int grid = 0;
    if (grid == 0) {
        if (n_in != 18 || in_sizes[0] != M * DM || out_size != M * DM || ws_size < WS_END) { fprintf(stderr, "kernel_launch: unexpected shapes (n_in %d, in0 %d, out %d, ws %zu)\n", n_in, n_in > 0 ? in_sizes[0] : -1, out_size, ws_size); grid = -1; return; }
        int dev = 0, cus = 0, per_cu = 0;
        if (hipGetDevice(&dev) != hipSuccess || hipDeviceGetAttribute(&cus, hipDeviceAttributeMultiprocessorCount, dev) != hipSuccess) { grid = -1; return; }
        if (hipFuncSetAttribute((const void*)mega_fwd, hipFuncAttributeMaxDynamicSharedMemorySize, LDS_BYTES) != hipSuccess) { fprintf(stderr, "kernel_launch: hipFuncSetAttribute failed\n"); grid = -1; return; }
        if (hipOccupancyMaxActiveBlocksPerMultiprocessor(&per_cu, (const void*)mega_fwd, 512, LDS_BYTES) != hipSuccess || per_cu < 1) { fprintf(stderr, "kernel_launch: occupancy query gave %d\n", per_cu); per_cu = 1; }
        (void)hipGetLastError();
        grid = cus * per_cu;
        fprintf(stderr, "kernel_launch: grid %d (%d CUs x %d)\n", grid, cus, per_cu);
    }
    if (grid < 0) return;
    if (hipMemsetAsync((char*)d_ws + WS_BAR, 0, BAR_BYTES, stream) != hipSuccess) { fprintf(stderr, "kernel_launch: memset failed\n"); return; }
    Args a{};
    for (int i = 0; i < 18; ++i) a.in[i] = (const float*)d_in[i];
    a.out = (float*)d_out; a.ws = (unsigned char*)d_ws;
    void* args[] = {&a};
    hipError_t e = hipLaunchCooperativeKernel((const void*)mega_fwd, dim3(grid), dim3(512), args, LDS_BYTES, stream);
    if (e != hipSuccess) fprintf(stderr, "kernel_launch: cooperative launch failed: %s (grid %d)\n", hipGetErrorString(e), grid);
}
```
